# Optimizing an MI355X kernel written in HIP

```python
import jax
import jax.numpy as jnp
from jax import lax
import numpy as np

D_MODEL = 1024
BATCH = 8
SEQ = 2048
DEPTH = 4

GRID_W = 64
CTX_LEN = 256
N_BRANCH = 4
BRANCH_W = D_MODEL // 2
RET_HEADS = 4
RET_DK = BRANCH_W // RET_HEADS
HG_HEADS = 4
HG_DK = BRANCH_W // HG_HEADS
NA_HEADS = 8
NA_HD = BRANCH_W // NA_HEADS
NA_KH = 8
NA_KW = 16
GQA_HEADS = 8
GQA_KV_HEADS = 2
GQA_HD = BRANCH_W // GQA_HEADS
GQA_KV_W = GQA_KV_HEADS * GQA_HD
GQA_BLOCK = 128
SCAN_CHUNK = 64
ROPE_BASE = 10000.0
N_EXPERTS = 32
TOP_K = 4
D_FF_EXPERT = D_MODEL
SWIGLU_LIMIT = 7.0
SWIGLU_ALPHA = 1.702
MOE_BLOCK = 256
LN_EPS = 1e-5
NORM_EPS = 1e-6
NEG_INF = -1e30
DN_ALPHA = (2 * DEPTH) ** 0.25
DN_BETA = (8 * DEPTH) ** -0.25
PROJ_WIDTHS = (BRANCH_W,) * 4 + (BRANCH_W,) * 5 + (BRANCH_W,) * 3 + (BRANCH_W, GQA_KV_W, GQA_KV_W, N_BRANCH * D_MODEL)
PROJ_TOTAL = sum(PROJ_WIDTHS)

kernel_name = 'hybrid_gated_ret_hgrn2_na_gqa_moe_dit'


def _heads(a, n):
    b, t, w = a.shape
    return a.reshape(b, t, n, w // n).transpose(0, 2, 1, 3)


def _merge_heads(a):
    b, n, t, d = a.shape
    return a.transpose(0, 2, 1, 3).reshape(b, t, n * d)


def _layernorm(x, g, b):
    xf = x.astype(jnp.float32)
    mu = jnp.mean(xf, -1, keepdims=True)
    var = jnp.mean(jnp.square(xf - mu), -1, keepdims=True)
    return ((xf - mu) * lax.rsqrt(var + LN_EPS) * g + b).astype(x.dtype)


def _rmsnorm(x, g):
    xf = x.astype(jnp.float32)
    return (xf * lax.rsqrt(jnp.mean(jnp.square(xf), -1, keepdims=True) + NORM_EPS) * g).astype(x.dtype)


def _grid_pos(t):
    idx = jnp.arange(t, dtype=jnp.int32)
    return (idx // GRID_W).astype(jnp.float32), (idx % GRID_W).astype(jnp.float32)


def _rotate(x, pos):
    n = x.shape[-1]
    inv = ROPE_BASE ** (-jnp.arange(0, n, 2, dtype=jnp.float32) / n)
    ang = pos[:, None] * inv[None, :]
    cos, sin = jnp.cos(ang), jnp.sin(ang)
    x1 = x[..., : n // 2].astype(jnp.float32)
    x2 = x[..., n // 2:].astype(jnp.float32)
    return jnp.concatenate([x1 * cos - x2 * sin, x1 * sin + x2 * cos], -1).astype(x.dtype)


def _rope2d(x, row, col):
    d = x.shape[-1]
    return jnp.concatenate([_rotate(x[..., : d // 2], row), _rotate(x[..., d // 2:], col)], -1)


def _attend(q, k, v):
    s = jnp.einsum('bhqd,bhkd->bhqk', q, k).astype(jnp.float32) * (q.shape[-1] ** -0.5)
    p = jax.nn.softmax(s, axis=-1)
    return jnp.einsum('bhqk,bhkd->bhqd', p.astype(v.dtype), v)


def _chunk_scan(q, k, v, logf, s0, include_diag):
    out_dtype = v.dtype
    b_, h_, t_, _ = q.shape
    dv = v.shape[-1]
    n = t_ // SCAN_CHUNK
    scalar_decay = logf.shape[-1] == 1
    mask = jnp.tril(jnp.ones((SCAN_CHUNK, SCAN_CHUNK), bool), 0 if include_diag else -1)

    def to_chunks(a):
        a = a.astype(jnp.float32)
        return jnp.moveaxis(a.reshape(b_, h_, n, SCAN_CHUNK, a.shape[-1]), 2, 0)

    def step(s, inp):
        qc, kc, vc, lf = inp
        cum = jnp.cumsum(lf, axis=2)
        seg = cum[:, :, :, None, :] - cum[:, :, None, :, :]
        dec = jnp.exp(jnp.where(mask[:, :, None], seg, -jnp.inf))
        if scalar_decay:
            a = jnp.einsum('bhid,bhjd->bhij', qc, kc) * dec[..., 0]
        else:
            a = jnp.einsum('bhid,bhjd,bhijd->bhij', qc, kc, dec)
        o = jnp.einsum('bhij,bhje->bhie', a, vc) + jnp.einsum('bhid,bhde->bhie', qc * jnp.exp(cum), s)
        last = cum[:, :, -1:, :]
        s_new = jnp.exp(last[:, :, 0, :])[..., None] * s + jnp.einsum('bhjd,bhje->bhde', kc * jnp.exp(last - cum), vc)
        return s_new, o

    s_fin, o = lax.scan(step, s0, (to_chunks(q), to_chunks(k), to_chunks(v), to_chunks(logf)))
    o = jnp.moveaxis(o, 0, 2).reshape(b_, h_, t_, dv)
    return o.astype(out_dtype), s_fin


def _bidir_prefix(lat_dirs, ctx_dirs, diags):
    outs_l, outs_c = [], []
    for d in range(2):
        lat, cx = lat_dirs[d], ctx_dirs[d]
        if d == 1:
            lat = tuple(jnp.flip(a, axis=2) for a in lat)
            cx = tuple(jnp.flip(a, axis=2) for a in cx)
        b_, h_, _, dk = cx[0].shape
        dv = cx[2].shape[-1]
        s0 = jnp.zeros((b_, h_, dk, dv), jnp.float32)
        o_c, s_c = _chunk_scan(cx[0], cx[1], cx[2], cx[3], s0, diags[d])
        o_l, _ = _chunk_scan(lat[0], lat[1], lat[2], lat[3], s_c, diags[d])
        if d == 1:
            o_c, o_l = jnp.flip(o_c, axis=2), jnp.flip(o_l, axis=2)
        outs_l.append(o_l)
        outs_c.append(o_c)
    return outs_l[0] + outs_l[1], outs_c[0] + outs_c[1]


def _retention(parts, parts_c, decay_logit, gn_g, gn_b, row, col):
    q, k, v, g = parts
    qc, kc, vc, gc = parts_c
    b_, t_, _ = q.shape
    l_ = qc.shape[1]
    log_gamma = jax.nn.log_sigmoid(decay_logit.astype(jnp.float32))

    def heads(q_, k_, v_):
        return _heads(q_, RET_HEADS), _heads(k_, RET_HEADS) * (RET_DK ** -0.5), _heads(v_, RET_HEADS)

    ql, kl, vl = heads(q, k, v)
    ql, kl = _rope2d(ql, row, col), _rope2d(kl, row, col)
    qx, kx, vx = heads(qc, kc, vc)

    def decay(d, t):
        return jnp.broadcast_to(log_gamma[d][None, :, None, None], (b_, RET_HEADS, t, 1))

    lat_dirs = [(ql, kl, vl, decay(d, t_)) for d in range(2)]
    ctx_dirs = [(qx, kx, vx, decay(d, l_)) for d in range(2)]
    o_l, o_c = _bidir_prefix(lat_dirs, ctx_dirs, (True, False))

    def out(o, gate):
        of = o.astype(jnp.float32)
        mu = jnp.mean(of, -1, keepdims=True)
        var = jnp.mean(jnp.square(of - mu), -1, keepdims=True)
        y = _merge_heads((of - mu) * lax.rsqrt(var + LN_EPS)) * gn_g + gn_b
        return (y * jax.nn.silu(gate.astype(jnp.float32))).astype(gate.dtype)

    return out(o_l, g), out(o_c, gc)


def _hgrn2(parts, parts_c, lower, norm_g):
    def prep(q, f_fwd, f_bwd, i):
        qh = _heads(jax.nn.silu(q), HG_HEADS)
        vh = _heads(i, HG_HEADS)
        dirs = []
        for d, f_raw in enumerate((f_fwd, f_bwd)):
            z = _heads(f_raw, HG_HEADS).astype(jnp.float32)
            lb = lower[d].reshape(1, HG_HEADS, 1, HG_DK)
            f = lb + (1.0 - lb) * jax.nn.sigmoid(z)
            key = (1.0 - lb) * jax.nn.sigmoid(-z)
            dirs.append((qh, key, vh, jnp.log(f)))
        return dirs

    o_l, o_c = _bidir_prefix(prep(*parts[:4]), prep(*parts_c[:4]), (True, True))

    def out(o, gate):
        of = o.astype(jnp.float32)
        on = of * lax.rsqrt(jnp.mean(jnp.square(of), -1, keepdims=True) + NORM_EPS)
        y = _merge_heads(on) * norm_g
        return (y * jax.nn.silu(gate.astype(jnp.float32))).astype(gate.dtype)

    return out(o_l, parts[4]), out(o_c, parts_c[4])


def _neighbourhood_attn(ql, kl, vl, qc, kc, vc, rpb):
    b_, t_, _ = ql.shape
    rows = t_ // GRID_W
    kh = min(NA_KH, rows)
    n_cb = GRID_W // NA_KW
    band = 2 * NA_KW
    scale = NA_HD ** -0.5

    def grid(a):
        return _heads(a, NA_HEADS).reshape(b_, NA_HEADS, rows, GRID_W, NA_HD)

    qg, kg, vg = grid(ql), grid(kl), grid(vl)
    r = jnp.arange(rows, dtype=jnp.int32)
    row_idx = jnp.clip(r - kh // 2, 0, rows - kh)[:, None] + jnp.arange(kh, dtype=jnp.int32)[None, :]
    cidx = jnp.arange(GRID_W, dtype=jnp.int32)
    col0 = jnp.clip(cidx - NA_KW // 2, 0, GRID_W - NA_KW)
    band_idx = (jnp.clip(jnp.arange(n_cb, dtype=jnp.int32) * NA_KW - NA_KW // 2, 0, GRID_W - band)[:, None]
                + jnp.arange(band, dtype=jnp.int32)[None, :])

    k_blk = kg[:, :, row_idx][:, :, :, :, band_idx]
    v_blk = vg[:, :, row_idx][:, :, :, :, band_idx]
    q_blk = qg.reshape(b_, NA_HEADS, rows, n_cb, NA_KW, NA_HD)
    s_loc = jnp.einsum('bhrjqd,bhrajkd->bhrjqak', q_blk, k_blk).astype(jnp.float32) * scale

    key_col = band_idx[:, None, :]
    q_col = cidx.reshape(n_cb, NA_KW)[:, :, None]
    q_col0 = col0.reshape(n_cb, NA_KW)[:, :, None]
    valid = (key_col >= q_col0) & (key_col < q_col0 + NA_KW)
    dr = row_idx - r[:, None] + (NA_KH - 1)
    dc = jnp.clip(key_col - q_col + (NA_KW - 1), 0, 2 * NA_KW - 2)
    bias = rpb[:, dr[:, None, None, :, None], dc[None, :, :, None, :]]
    s_loc = jnp.where(valid[:, :, None, :], s_loc + bias.astype(jnp.float32), NEG_INF)

    qx, kx, vx = _heads(qc, NA_HEADS), _heads(kc, NA_HEADS), _heads(vc, NA_HEADS)
    s_ctx = jnp.einsum('bhrjqd,bhld->bhrjql', q_blk, kx).astype(jnp.float32) * scale
    n_loc = kh * band
    s_all = jnp.concatenate([s_loc.reshape(b_, NA_HEADS, rows, n_cb, NA_KW, n_loc), s_ctx], -1)
    p = jax.nn.softmax(s_all, axis=-1).astype(vl.dtype)
    p_loc = p[..., :n_loc].reshape(b_, NA_HEADS, rows, n_cb, NA_KW, kh, band)
    o = (jnp.einsum('bhrjqak,bhrajkd->bhrjqd', p_loc, v_blk)
         + jnp.einsum('bhrjql,bhld->bhrjqd', p[..., n_loc:], vx))
    o_lat = _merge_heads(o.reshape(b_, NA_HEADS, t_, NA_HD))
    o_ctx = _merge_heads(_attend(qx, kx, vx))
    return o_lat, o_ctx


def _gqa_attend(q, k, v):
    s = jnp.einsum('bhgqd,bhkd->bhgqk', q, k).astype(jnp.float32) * (q.shape[-1] ** -0.5)
    p = jax.nn.softmax(s, axis=-1)
    return jnp.einsum('bhgqk,bhkd->bhgqd', p.astype(v.dtype), v)


def _gqa(ql, kl, vl, qc, kc, vc, qn_g, kn_g, row, col):
    b_, t_, _ = ql.shape
    grp = GQA_HEADS // GQA_KV_HEADS

    def q_heads(a):
        return a.reshape(b_, a.shape[1], GQA_KV_HEADS, grp, GQA_HD).transpose(0, 2, 3, 1, 4)

    qlh = _rope2d(_rmsnorm(q_heads(ql), qn_g), row, col)
    klh = _rope2d(_rmsnorm(_heads(kl, GQA_KV_HEADS), kn_g), row, col)
    qch = _rmsnorm(q_heads(qc), qn_g)
    kch = _rmsnorm(_heads(kc, GQA_KV_HEADS), kn_g)
    vlh, vch = _heads(vl, GQA_KV_HEADS), _heads(vc, GQA_KV_HEADS)
    k_all = jnp.concatenate([klh, kch], axis=2)
    v_all = jnp.concatenate([vlh, vch], axis=2)
    nb = t_ // GQA_BLOCK
    q_blocks = jnp.moveaxis(qlh.reshape(b_, GQA_KV_HEADS, grp, nb, GQA_BLOCK, GQA_HD), 3, 0)
    o = lax.map(lambda qb: _gqa_attend(qb, k_all, v_all), q_blocks)
    o = jnp.moveaxis(o, 0, 3).reshape(b_, GQA_KV_HEADS, grp, t_, GQA_HD)
    o_lat = o.transpose(0, 3, 1, 2, 4).reshape(b_, t_, GQA_HEADS * GQA_HD)
    oc = _gqa_attend(qch, kch, vch)
    o_ctx = oc.transpose(0, 3, 1, 2, 4).reshape(b_, qc.shape[1], GQA_HEADS * GQA_HD)
    return o_lat, o_ctx


def _merge_branches(outs, gate_raw, w_branch, w_out):
    b_, t_, _ = gate_raw.shape
    yb = jnp.einsum('btnw,nwd->btnd', jnp.stack(outs, axis=2), w_branch)
    g = jax.nn.sigmoid(gate_raw.reshape(b_, t_, N_BRANCH, D_MODEL))
    return jnp.sum(g * yb, axis=2) @ w_out


def _moe(h, w_router, b_router, w_gu, b_gu, w_down, b_down):
    n_tok, d = h.shape
    logits = (h @ w_router).astype(jnp.float32) + b_router.astype(jnp.float32)
    top_val, top_idx = lax.top_k(logits, TOP_K)
    gate = jax.nn.softmax(top_val, axis=-1)
    nk = n_tok * TOP_K
    flat_e = top_idx.reshape(nk).astype(jnp.int32)
    flat_t = jnp.arange(nk, dtype=jnp.int32) // TOP_K
    order = jnp.argsort(flat_e)
    e_s, t_s, g_s = flat_e[order], flat_t[order], gate.reshape(nk)[order]
    counts = jnp.zeros((N_EXPERTS,), jnp.int32).at[flat_e].add(1)
    padded = (counts + MOE_BLOCK - 1) // MOE_BLOCK * MOE_BLOCK
    start_s = jnp.cumsum(counts) - counts
    ends_p = jnp.cumsum(padded)
    start_p = ends_p - padded
    dest = start_p[e_s] + (jnp.arange(nk, dtype=jnp.int32) - start_s[e_s])
    n_blocks = (nk + N_EXPERTS * (MOE_BLOCK - 1) + MOE_BLOCK - 1) // MOE_BLOCK
    n_slots = n_blocks * MOE_BLOCK
    slot_tok = jnp.full((n_slots,), n_tok, jnp.int32).at[dest].set(t_s)
    slot_gate = jnp.zeros((n_slots,), jnp.float32).at[dest].set(g_s)
    block_start = jnp.arange(n_blocks, dtype=jnp.int32) * MOE_BLOCK
    block_e = jnp.minimum(jnp.sum(ends_p[None, :] <= block_start[:, None], axis=1), N_EXPERTS - 1)
    h_pad = jnp.concatenate([h, jnp.zeros((1, d), h.dtype)], axis=0)
    xb = h_pad[slot_tok].reshape(n_blocks, MOE_BLOCK, d)

    def expert_block(args):
        xe, e = args
        gu = xe @ w_gu[e] + b_gu[e]
        g_, u_ = gu[:, :D_FF_EXPERT], gu[:, D_FF_EXPERT:]
        g_ = jnp.minimum(g_, SWIGLU_LIMIT)
        u_ = jnp.clip(u_, -SWIGLU_LIMIT, SWIGLU_LIMIT)
        act = g_ * jax.nn.sigmoid(SWIGLU_ALPHA * g_) * (u_ + 1.0)
        return act @ w_down[e] + b_down[e]

    yb = lax.map(expert_block, (xb, block_e))
    y = yb.reshape(n_slots, d) * slot_gate[:, None].astype(yb.dtype)
    return jnp.zeros((n_tok + 1, d), y.dtype).at[slot_tok].add(y)[:n_tok]


def setup_inputs(seed: int = 0) -> dict:
    key = jax.random.key(seed)
    ks = jax.random.split(key, 26)

    def nrm(k, shape, scale):
        return jax.random.normal(k, shape, jnp.float32) * scale

    d = D_MODEL
    p = 5.0 + jnp.arange(RET_HEADS, dtype=jnp.float32)
    ret_base = jnp.log(2.0 ** p - 1.0)
    return {
        'x': nrm(ks[0], (BATCH, SEQ, d), 1.0),
        'c': nrm(ks[1], (BATCH, d), 1.0),
        'ctx': nrm(ks[2], (BATCH, CTX_LEN, d), 1.0),
        'c_ctx': nrm(ks[3], (d,), 1.0),
        'w_mod': nrm(ks[4], (DEPTH, d, 6 * d), d ** -0.5),
        'b_mod': nrm(ks[5], (DEPTH, 6 * d), 0.02),
        'w_in': nrm(ks[6], (DEPTH, d, PROJ_TOTAL), d ** -0.5),
        'ret_decay': ret_base[None, None, :] + nrm(ks[7], (DEPTH, 2, RET_HEADS), 0.05),
        'ret_gn_g': 1.0 + nrm(ks[8], (DEPTH, BRANCH_W), 0.02),
        'ret_gn_b': nrm(ks[9], (DEPTH, BRANCH_W), 0.02),
        'hg_lb': 1.0 + nrm(ks[10], (2, DEPTH, BRANCH_W), 0.1),
        'hg_norm_g': 1.0 + nrm(ks[11], (DEPTH, BRANCH_W), 0.02),
        'na_rpb': nrm(ks[12], (DEPTH, NA_HEADS, 2 * NA_KH - 1, 2 * NA_KW - 1), 0.1),
        'gq_qn_g': 1.0 + nrm(ks[13], (DEPTH, GQA_HD), 0.02),
        'gq_kn_g': 1.0 + nrm(ks[14], (DEPTH, GQA_HD), 0.02),
        'w_branch': nrm(ks[15], (DEPTH, N_BRANCH, BRANCH_W, d), BRANCH_W ** -0.5),
        'w_out': nrm(ks[16], (DEPTH, d, d), d ** -0.5 * DN_BETA),
        'ln_g': 1.0 + nrm(ks[17], (DEPTH, 2, d), 0.02),
        'ln_b': nrm(ks[18], (DEPTH, 2, d), 0.02),
        'w_router': nrm(ks[19], (DEPTH, d, N_EXPERTS), d ** -0.5),
        'b_router': nrm(ks[20], (DEPTH, N_EXPERTS), 0.01),
        'w_gu': nrm(ks[21], (DEPTH, N_EXPERTS, d, 2 * D_FF_EXPERT), d ** -0.5),
        'b_gu': nrm(ks[22], (DEPTH, N_EXPERTS, 2 * D_FF_EXPERT), 0.02),
        'w_down': nrm(ks[23], (DEPTH, N_EXPERTS, D_FF_EXPERT, d), D_FF_EXPERT ** -0.5 * DN_BETA),
        'b_down': nrm(ks[24], (DEPTH, N_EXPERTS, d), 0.02),
    }


def reference(x, c, ctx, c_ctx, w_mod, b_mod, w_in, ret_decay, ret_gn_g, ret_gn_b, hg_lb, hg_norm_g,
              na_rpb, gq_qn_g, gq_kn_g, w_branch, w_out, ln_g, ln_b, w_router, b_router, w_gu, b_gu,
              w_down, b_down):
    b_, t_, d = x.shape
    row, col = _grid_pos(t_)
    sm = jax.nn.softmax(hg_lb.astype(jnp.float32), axis=1)
    lower = jnp.cumsum(sm, axis=1) - sm[:, :1]
    split_at = np.cumsum(PROJ_WIDTHS)[:-1].tolist()
    silu_c = jax.nn.silu(c)
    silu_cc = jax.nn.silu(c_ctx)
    xc = ctx
    for l in range(DEPTH):
        last = l == DEPTH - 1
        sh1, sc1, g1, sh2, sc2, g2 = jnp.split((silu_c @ w_mod[l] + b_mod[l])[:, None, :], 6, axis=-1)
        csh1, csc1, cg1, csh2, csc2, cg2 = jnp.split(silu_cc @ w_mod[l] + b_mod[l], 6, axis=-1)
        h = x * (1.0 + sc1) + sh1
        hc = xc * (1.0 + csc1) + csh1
        z = jnp.split(h @ w_in[l], split_at, axis=-1)
        zc = jnp.split(hc @ w_in[l], split_at, axis=-1)
        ret_l, ret_c = _retention(z[0:4], zc[0:4], ret_decay[l], ret_gn_g[l], ret_gn_b[l], row, col)
        hg_l, hg_c = _hgrn2(z[4:9], zc[4:9], lower[:, l], hg_norm_g[l])
        na_l, na_c = _neighbourhood_attn(z[9], z[10], z[11], zc[9], zc[10], zc[11], na_rpb[l])
        gq_l, gq_c = _gqa(z[12], z[13], z[14], zc[12], zc[13], zc[14], gq_qn_g[l], gq_kn_g[l], row, col)
        y = _merge_branches((ret_l, hg_l, na_l, gq_l), z[15], w_branch[l], w_out[l])
        x = _layernorm(DN_ALPHA * x + g1 * y, ln_g[l, 0], ln_b[l, 0])
        h2 = (x * (1.0 + sc2) + sh2).reshape(b_ * t_, d)
        if last:
            y2 = _moe(h2, w_router[l], b_router[l], w_gu[l], b_gu[l], w_down[l], b_down[l]).reshape(b_, t_, d)
        else:
            yc = _merge_branches((ret_c, hg_c, na_c, gq_c), zc[15], w_branch[l], w_out[l])
            xc = _layernorm(DN_ALPHA * xc + cg1 * yc, ln_g[l, 0], ln_b[l, 0])
            h2c = (xc * (1.0 + csc2) + csh2).reshape(-1, d)
            y_all = _moe(jnp.concatenate([h2, h2c], axis=0), w_router[l], b_router[l], w_gu[l], b_gu[l],
                         w_down[l], b_down[l])
            y2 = y_all[: b_ * t_].reshape(b_, t_, d)
            y2c = y_all[b_ * t_:].reshape(xc.shape)
            xc = _layernorm(DN_ALPHA * xc + cg2 * y2c, ln_g[l, 1], ln_b[l, 1])
        x = _layernorm(DN_ALPHA * x + g2 * y2, ln_g[l, 1], ln_b[l, 1])
    return x
```

```cpp
#include <hip/hip_runtime.h>
#include <cstdio>
#include <cstdint>

#ifndef MK_PER_PHASE
#define MK_PER_PHASE 0
#endif
#ifndef PROBE_DUP_MASK
#define PROBE_DUP_MASK 0
#endif
#define XB_TMO      128
#define XB_XCNT(j)  (256  + 64 * (j))
#define XB_XSUB(j)  (1280 + 64 * (j))
#define XB_XGEN(j)  (2304 + 64 * (j))
#define XB_TOP      3328
#define XB_TOPGEN   3392
#define XCD_BAR_WORDS 3456
#define XB_SPIN_CAP (1u << 18)
#define LAS __attribute__((address_space(3)))

__device__ __forceinline__ unsigned xb_ld(unsigned* p)              { return __hip_atomic_load(p, __ATOMIC_RELAXED, __HIP_MEMORY_SCOPE_AGENT); }
__device__ __forceinline__ unsigned xb_add(unsigned* p, unsigned v) { return __hip_atomic_fetch_add(p, v, __ATOMIC_RELAXED, __HIP_MEMORY_SCOPE_AGENT); }
__device__ __forceinline__ unsigned xb_xcc_id() { return (unsigned)__builtin_amdgcn_s_getreg((3 << 11) | 20) & 0xFu; }
#define XB_SPIN(cond, bar) do { unsigned _sp = 0; while (cond) { __builtin_amdgcn_s_sleep(1); \
    if ((++_sp & 255u) == 0u) { if (xb_ld(&(bar)[XB_TMO])) break; if (_sp > XB_SPIN_CAP) { atomicAdd(&(bar)[XB_TMO], 1u); break; } } } } while (0)

struct XcdBarrier {
    unsigned* bar; unsigned x;
    volatile LAS unsigned* st;
};

__device__ __forceinline__ XcdBarrier xcd_barrier_post(unsigned* bar, volatile LAS unsigned* st) {
    XcdBarrier b; b.bar = bar; b.x = xb_xcc_id(); b.st = st;
    if (threadIdx.x == 0) (void)xb_add(&bar[XB_XCNT(b.x)], 1u);
    return b;
}
__device__ __forceinline__ void xcd_barrier_complete(unsigned* bar, unsigned x, unsigned& nloc, unsigned& nx) {
    const unsigned G = gridDim.x * gridDim.y * gridDim.z;
    unsigned sum, cnt, mine, sp = 0u;
    for (;;) {
        sum = 0u; cnt = 0u; mine = 0u;
#pragma unroll
        for (unsigned j = 0; j < 16; ++j) { const unsigned c = xb_ld(&bar[XB_XCNT(j)]); sum += c; cnt += (c > 0u) ? 1u : 0u; mine = (j == x) ? c : mine; }
        if (sum == G) break;
        __builtin_amdgcn_s_sleep(1);
        if ((++sp & 255u) == 0u) { if (xb_ld(&bar[XB_TMO])) break; if (sp > XB_SPIN_CAP) { atomicAdd(&bar[XB_TMO], 1u); break; } }
    }
    nloc = mine > 0u ? mine : 1u; nx = cnt > 0u ? cnt : 1u;
}

__device__ __forceinline__ void xcd_barrier(const XcdBarrier& b) {
    asm volatile("s_waitcnt vmcnt(0)" ::: "memory");
    __syncthreads();
    if (threadIdx.x == 0) {
        unsigned* bar = b.bar;
        __builtin_amdgcn_s_waitcnt(0);
        unsigned nloc = b.st[0], nx = b.st[1];
        if (nloc == 0u) { xcd_barrier_complete(bar, b.x, nloc, nx); b.st[0] = nloc; b.st[1] = nx; }
        const unsigned old = xb_add(&bar[XB_XSUB(b.x)], 1u);
        const unsigned gen = old / nloc;
        if (old + 1u == (gen + 1u) * nloc) {
            __builtin_amdgcn_fence(__ATOMIC_RELEASE, "agent");
            asm volatile("s_waitcnt vmcnt(0)" ::: "memory");
            const unsigned og = xb_add(&bar[XB_TOP], 1u);
            const unsigned tg = og / nx;
            if (og + 1u == (tg + 1u) * nx) xb_add(&bar[XB_TOPGEN], 1u);
            else XB_SPIN(xb_ld(&bar[XB_TOPGEN]) == tg, bar);
            __builtin_amdgcn_fence(__ATOMIC_ACQUIRE, "agent");
            xb_add(&bar[XB_XGEN(b.x)], 1u);
            asm volatile("s_waitcnt vmcnt(0)" ::: "memory");
        } else {
            XB_SPIN(xb_ld(&bar[XB_XGEN(b.x)]) == gen, bar);
            __builtin_amdgcn_fence(__ATOMIC_ACQUIRE, "agent");
            asm volatile("s_waitcnt vmcnt(0)" ::: "memory");
        }
    }
    __syncthreads();
}
namespace pg8 {
#define PG8_LAS __attribute__((address_space(3)))
typedef unsigned short bf16_t;
typedef short bf16x8 __attribute__((ext_vector_type(8)));
typedef float f32x4 __attribute__((ext_vector_type(4)));
typedef unsigned u32x4 __attribute__((ext_vector_type(4)));
constexpr int BM = 256, BK = 64, HALF = 128, HTB = HALF * BK * 2  , STAGE_BYTES = 8 * HTB, NXCD = 8, WGM = 8;

__host__ __device__ __forceinline__ int lds_byte(int r, int c) { const int st = (r >> 4) * 2 + (c >> 5), rr = r & 15, cc = c & 31, ob = rr * 64 + cc * 2; return st * 1024 + (ob ^ (((ob >> 9) & 1) << 5)); }
__host__ __device__ __forceinline__ void stage_rc(int b, int& R, int& C) { const int st = b / 1024, sb = b % 1024, swz = sb ^ (((sb >> 9) & 1) << 5); R = (st >> 1) * 16 + swz / 64; C = (st & 1) * 32 + (swz % 64) / 2; }
__host__ __device__ __forceinline__ int perm32(int rho) { const int n = rho >> 4, i = rho & 15; return 8 * (i >> 2) + 4 * n + (i & 3); }

struct Unit { int pm, pn; };
struct Gemm { const bf16_t* A; const bf16_t* Bt; int M, N, K; const int* stok; };

struct StaticOrder {
    int nM, nN, nwg, G, c;
    __host__ __device__ void init(int M, int N, int G_, int c_) { nM = M / BM; nN = N / BM; nwg = nM * nN; G = G_; c = c_; }
    __host__ __device__ bool next(int i, Unit& u) const {
        const long L = (long)i * G + c; if (L >= nwg) return false;
        int wgid = (int)L; { const int q = nwg / NXCD, r = nwg % NXCD, xcd = wgid % NXCD, off = wgid / NXCD; wgid = (xcd < r ? xcd * (q + 1) : r * (q + 1) + (xcd - r) * q) + off; }
        const int nig = WGM * nN, gid = wgid / nig, fm = gid * WGM, gsz = (nM - fm) < WGM ? (nM - fm) : WGM;
        u.pm = fm + ((wgid % nig) % gsz); u.pn = (wgid % nig) / gsz; return true;
    }
    __device__ __forceinline__ void a_ready(const Unit&) const {}
    __device__ __forceinline__ void done(const Unit&) const {}
};

__device__ __forceinline__ unsigned cvt_pk_bf16(float lo, float hi) { unsigned r; asm volatile("v_cvt_pk_bf16_f32 %0, %1, %2" : "=v"(r) : "v"(lo), "v"(hi)); return r; }
template <class Epi, class Sched, bool ALIGN_EPI = false, bool SP2 = false, bool GATHER = false>
__device__ __forceinline__ void gemm_phase(PG8_LAS unsigned char* lds, const Gemm g, const Sched& S, const Epi& E) {
    int tid_ = threadIdx.x; asm volatile("" : "+v"(tid_));
    const int tid = tid_, wid = __builtin_amdgcn_readfirstlane(tid >> 6), lane = tid & 63, wr = wid >> 2, wc = wid & 3, fr = lane & 15, fq = lane >> 4;
    const int K = g.K, nt = K / BK;
    unsigned voffA[2], voffB[2];
#pragma unroll
    for (int i = 0; i < 2; ++i) { int R, C; stage_rc(tid * 16 + i * 8192, R, C); const int Rb = Epi::PERM ? ((R & ~31) + perm32(R & 31)) : R;
        voffA[i] = (unsigned)(R * K + C) * 2u; voffB[i] = (unsigned)(Rb * K + C) * 2u; }
    static_assert(!GATHER || SP2, "GATHER is wired into the SP2 loop only");
    int gR[2], gC[2]; unsigned vA0[2], vA1[2], vN0[2], vN1[2];
    if constexpr (GATHER) {
#pragma unroll
        for (int i = 0; i < 2; ++i) { stage_rc(tid * 16 + i * 8192, gR[i], gC[i]); vA0[i] = vA1[i] = vN0[i] = vN1[i] = 0u; }
    }
#define PG8_GOFFS(pm_, d0, d1) do { _Pragma("unroll") for (int _i = 0; _i < 2; ++_i) { \
        (d0)[_i] = (unsigned)(g.stok[(pm_) * BM + gR[_i]] * K + gC[_i]) * 2u; (d1)[_i] = (unsigned)(g.stok[(pm_) * BM + HALF + gR[_i]] * K + gC[_i]) * 2u; } } while (0)
#define PG8_STAGE_A(bufoff, ngbase, gbase, gvoff) do { if constexpr (GATHER) { PG8_STAGE(bufoff, gbase, gvoff); } else { PG8_STAGE(bufoff, ngbase, voffA); } } while (0)
    const size_t kstep = (size_t)(BK * 2);
    const size_t hstep = (size_t)HALF * K * 2;
    const size_t tstep = 2 * hstep;
    const unsigned ldsw = (unsigned)wid * 1024u;
    const int aoff = lds_byte(wr * 64 + fr, fq * 8), boff = lds_byte(wc * 32 + fr, fq * 8);
#define PG8_SA(b, h) (((b) * 2 + (h)) * HTB)
#define PG8_SB(b, h) ((4 + (b) * 2 + (h)) * HTB)
#define PG8_STAGE(bufoff, gbase, voff) do { _Pragma("unroll") for (int _i = 0; _i < 2; ++_i) \
        __builtin_amdgcn_global_load_lds((const unsigned*)((const char*)(gbase) + (voff)[_i]), (PG8_LAS unsigned*)(lds + (bufoff) + ldsw + _i * 8192), 16, 0, 0); } while (0)
#define PG8_LDA(dst, b, h) do { _Pragma("unroll") for (int m = 0; m < 4; ++m) _Pragma("unroll") for (int k = 0; k < 2; ++k) dst[m][k] = *(const PG8_LAS bf16x8*)(lds + PG8_SA(b, h) + aoff + m * 2048 + k * 1024); } while (0)
#define PG8_LDB(dst, b, h) do { _Pragma("unroll") for (int n = 0; n < 2; ++n) _Pragma("unroll") for (int k = 0; k < 2; ++k) dst[n][k] = *(const PG8_LAS bf16x8*)(lds + PG8_SB(b, h) + boff + n * 2048 + k * 1024); } while (0)
#define PG8_MMA(ai, bj, At, Bt) do { __builtin_amdgcn_s_setprio(1); _Pragma("unroll") for (int m = 0; m < 4; ++m) _Pragma("unroll") for (int n = 0; n < 2; ++n) _Pragma("unroll") for (int k = 0; k < 2; ++k) \
        acc[ai][bj][m][n] = __builtin_amdgcn_mfma_f32_16x16x32_bf16(Bt[n][k], At[m][k], acc[ai][bj][m][n], 0, 0, 0); __builtin_amdgcn_s_setprio(0); } while (0)
#define PG8_WAIT_V(n) asm volatile("s_waitcnt vmcnt(" #n ")" ::: "memory")
#define PG8_WAIT_L(n) asm volatile("s_waitcnt lgkmcnt(" #n ")" ::: "memory")
#define PG8_BAR __builtin_amdgcn_s_barrier()
#define PG8_SCHED __builtin_amdgcn_sched_barrier(0)
    Unit cur, nxt; int ui = 0;
    if (!S.next(0, cur)) return;
    f32x4 acc[2][2][4][2];
#pragma unroll
    for (int a = 0; a < 2; ++a)
#pragma unroll
        for (int b = 0; b < 2; ++b)
#pragma unroll
            for (int m = 0; m < 4; ++m)
#pragma unroll
                for (int n = 0; n < 2; ++n) acc[a][b][m][n] = (f32x4){0.f, 0.f, 0.f, 0.f};
    bf16x8 At[4][2], B0[2][2], B1[2][2];
    const char* cA = (const char*)g.A + (size_t)cur.pm * tstep; const char* cB = (const char*)g.Bt + (size_t)cur.pn * tstep;
    const char* const gA = (const char*)g.A;
    if constexpr (GATHER) { PG8_GOFFS(cur.pm, vA0, vA1); }
    S.a_ready(cur);
    if constexpr (SP2) {
        PG8_STAGE(PG8_SB(0, 0), cB, voffB); PG8_STAGE(PG8_SB(0, 1), cB + hstep, voffB); PG8_STAGE_A(PG8_SA(0, 0), cA, gA, vA0); PG8_STAGE_A(PG8_SA(0, 1), cA + hstep, gA, vA1);
        if (wr == 1) PG8_BAR;
        PG8_WAIT_V(2); PG8_BAR;
        PG8_STAGE(PG8_SB(1, 0), cB + kstep, voffB); PG8_STAGE_A(PG8_SA(1, 0), cA + kstep, gA + kstep, vA0); PG8_STAGE(PG8_SB(1, 1), cB + hstep + kstep, voffB);
        PG8_WAIT_V(6); PG8_BAR;
    } else {
        PG8_STAGE(PG8_SB(0, 0), cB, voffB); PG8_STAGE(PG8_SA(0, 0), cA, voffA); PG8_STAGE(PG8_SB(0, 1), cB + hstep, voffB); PG8_STAGE(PG8_SA(0, 1), cA + hstep, voffA);
        if (wr == 1) PG8_BAR;
        PG8_WAIT_V(4); PG8_BAR;
        PG8_STAGE(PG8_SB(1, 0), cB + kstep, voffB); PG8_STAGE(PG8_SA(1, 0), cA + kstep, voffA); PG8_STAGE(PG8_SB(1, 1), cB + hstep + kstep, voffB);
        PG8_WAIT_V(6); PG8_BAR;
    }
    for (;;) {
        const bool has_next = S.next(ui + 1, nxt);
        if constexpr (GATHER) { if (has_next) { PG8_GOFFS(nxt.pm, vN0, vN1); } else { vN0[0] = vA0[0]; vN0[1] = vA0[1]; vN1[0] = vA1[0]; vN1[1] = vA1[1]; } }
        const char* nA = has_next ? (const char*)g.A + (size_t)nxt.pm * tstep : cA; const char* nB = has_next ? (const char*)g.Bt + (size_t)nxt.pn * tstep : cB;
        for (int t = 0; t < nt; t += 2) {
            const bool last = (t == nt - 2);
            const char* a1 = cA + (size_t)(t + 1) * kstep;
            const char* a2 = last ? nA : cA + (size_t)(t + 2) * kstep; const char* b2 = last ? nB : cB + (size_t)(t + 2) * kstep;
            const char* a3 = a2 + kstep; const char* b3 = b2 + kstep;
            if (last && has_next) S.a_ready(nxt);
            if constexpr (SP2) {
            unsigned s0[2], s1[2]; const char* g2 = gA;
            if constexpr (GATHER) { s0[0] = last ? vN0[0] : vA0[0]; s0[1] = last ? vN0[1] : vA0[1]; s1[0] = last ? vN1[0] : vA1[0]; s1[1] = last ? vN1[1] : vA1[1]; g2 = gA + (last ? (size_t)0 : (size_t)(t + 2) * kstep); }
            PG8_LDB(B0, 0, 0); PG8_LDB(B1, 0, 1); PG8_SCHED; PG8_LDA(At, 0, 0); PG8_STAGE_A(PG8_SA(1, 1), a1 + hstep, gA + (size_t)(t + 1) * kstep, vA1);
            PG8_WAIT_V(8); PG8_WAIT_L(0); PG8_BAR; PG8_MMA(0, 0, At, B0); PG8_MMA(0, 1, At, B1); PG8_BAR; PG8_SCHED;
            PG8_LDA(At, 0, 1); PG8_STAGE(PG8_SB(0, 0), b2, voffB); PG8_STAGE(PG8_SB(0, 1), b2 + hstep, voffB); PG8_STAGE_A(PG8_SA(0, 0), a2, g2, s0);
            PG8_WAIT_V(8); PG8_WAIT_L(0); PG8_BAR; PG8_MMA(1, 0, At, B0); PG8_MMA(1, 1, At, B1); PG8_BAR; PG8_SCHED;
            PG8_LDB(B0, 1, 0); PG8_LDB(B1, 1, 1); PG8_SCHED; PG8_LDA(At, 1, 0); PG8_STAGE_A(PG8_SA(0, 1), a2 + hstep, g2, s1);
            PG8_WAIT_V(8); PG8_WAIT_L(0); PG8_BAR; PG8_MMA(0, 0, At, B0); PG8_MMA(0, 1, At, B1); PG8_BAR; PG8_SCHED;
            PG8_LDA(At, 1, 1); PG8_STAGE(PG8_SB(1, 0), b3, voffB); PG8_STAGE(PG8_SB(1, 1), b3 + hstep, voffB); PG8_STAGE_A(PG8_SA(1, 0), a3, g2 + kstep, s0);
            PG8_WAIT_V(8); PG8_WAIT_L(0); PG8_BAR; PG8_MMA(1, 0, At, B0); PG8_MMA(1, 1, At, B1); PG8_BAR; PG8_SCHED;
            } else {
            PG8_LDB(B0, 0, 0); PG8_SCHED; PG8_LDA(At, 0, 0); PG8_STAGE(PG8_SA(1, 1), a1 + hstep, voffA);
            PG8_WAIT_L(8); PG8_BAR; PG8_WAIT_L(0); PG8_MMA(0, 0, At, B0); PG8_BAR; PG8_SCHED;
            PG8_LDB(B1, 0, 1); PG8_STAGE(PG8_SB(0, 0), b2, voffB);
            PG8_BAR; PG8_WAIT_L(0); PG8_MMA(0, 1, At, B1); PG8_BAR;
            PG8_LDA(At, 0, 1); PG8_STAGE(PG8_SA(0, 0), a2, voffA);
            PG8_BAR; PG8_WAIT_L(0); PG8_MMA(1, 0, At, B0); PG8_BAR; PG8_SCHED;
            PG8_STAGE(PG8_SB(0, 1), b2 + hstep, voffB);
            PG8_WAIT_V(6); PG8_BAR; PG8_MMA(1, 1, At, B1); PG8_BAR;
            PG8_LDB(B0, 1, 0); PG8_SCHED; PG8_LDA(At, 1, 0); PG8_STAGE(PG8_SA(0, 1), a2 + hstep, voffA);
            PG8_WAIT_L(8); PG8_BAR; PG8_WAIT_L(0); PG8_MMA(0, 0, At, B0); PG8_BAR; PG8_SCHED;
            PG8_LDB(B1, 1, 1); PG8_STAGE(PG8_SB(1, 0), b3, voffB);
            PG8_BAR; PG8_WAIT_L(0); PG8_MMA(0, 1, At, B1); PG8_BAR;
            PG8_LDA(At, 1, 1); PG8_STAGE(PG8_SA(1, 0), a3, voffA);
            PG8_BAR; PG8_WAIT_L(0); PG8_MMA(1, 0, At, B0); PG8_BAR; PG8_SCHED;
            PG8_STAGE(PG8_SB(1, 1), b3 + hstep, voffB);
            PG8_WAIT_V(6); PG8_BAR; PG8_MMA(1, 1, At, B1); PG8_BAR;
            }
        }
        if constexpr (ALIGN_EPI) { if (wr == 0) PG8_BAR; }
        if constexpr (!Epi::AFTER_DRAIN) { E(acc, cur, wr, wc, fr, fq); S.done(cur); }
        if (!has_next) break;
#pragma unroll
        for (int a = 0; a < 2; ++a)
#pragma unroll
            for (int b = 0; b < 2; ++b)
#pragma unroll
                for (int m = 0; m < 4; ++m)
#pragma unroll
                    for (int n = 0; n < 2; ++n) acc[a][b][m][n] = (f32x4){0.f, 0.f, 0.f, 0.f};
        cur = nxt; cA = nA; cB = nB; ++ui;
        if constexpr (GATHER) { vA0[0] = vN0[0]; vA0[1] = vN0[1]; vA1[0] = vN1[0]; vA1[1] = vN1[1]; }
        if constexpr (ALIGN_EPI) { if (wr == 1) PG8_BAR; }
    }
    PG8_WAIT_V(0);
    if constexpr (!ALIGN_EPI) { if (wr == 0) PG8_BAR; }
    PG8_BAR;
    if constexpr (Epi::AFTER_DRAIN) { E.fused(acc, cur, wr, wc, fr, fq, lds, wid, lane); S.done(cur); }
#undef PG8_GOFFS
#undef PG8_STAGE_A
#undef PG8_SA
#undef PG8_SB
#undef PG8_STAGE
#undef PG8_LDA
#undef PG8_LDB
#undef PG8_MMA
#undef PG8_WAIT_V
#undef PG8_WAIT_L
#undef PG8_BAR
#undef PG8_SCHED
}
}

typedef unsigned short bf16;
typedef short bf16x8 __attribute__((ext_vector_type(8)));
typedef float f32x4 __attribute__((ext_vector_type(4)));
typedef unsigned u32x4 __attribute__((ext_vector_type(4)));
typedef unsigned u32x2 __attribute__((ext_vector_type(2)));

constexpr int D = 1024, NB = 8, SEQ = 2048, DEPTH = 4, CTXL = 256;
constexpr int ML = NB * SEQ, MC = NB * CTXL, M = ML + MC, MT = M / 256;
constexpr int PROJ = 11008;
constexpr int C_RQ = 0, C_RK = 512, C_RV = 1024, C_RG = 1536, C_HQ = 2048, C_HF = 2560, C_HI = 3584, C_HG = 4096;
constexpr int C_NQ = 4608, C_NK = 5120, C_NV = 5632, C_GQ = 6144, C_GK = 6656, C_GV = 6784, C_GATE = 6912;
constexpr int NEXP = 32, NSLOT = 320 * 256, MAXTILES = 320;
constexpr float DN_ALPHA = 1.681792830507429f;
constexpr float LN_EPS = 1e-5f, NORM_EPS = 1e-6f;

enum { I_X = 0, I_C, I_CTX, I_CCTX, I_WMOD, I_BMOD, I_WIN, I_RDEC, I_RGNG, I_RGNB, I_HLB, I_HNG, I_RPB, I_QNG, I_KNG, I_WBR, I_WOUT, I_LNG, I_LNB, I_WR, I_BR, I_WGU, I_BGU, I_WDN, I_BDN };

constexpr size_t MiB = 1u << 20;
constexpr size_t WS_CTL = 0, CTL_ZERO_BYTES = 1 * MiB;
constexpr size_t WS_MODV = 1 * MiB;
constexpr size_t WS_LOWER = WS_MODV + 896 * 1024;
constexpr size_t WS_ROPEA = WS_MODV + 912 * 1024;
constexpr size_t WS_ROPEB = WS_MODV + 928 * 1024;
constexpr size_t WS_HIST = WS_MODV + 944 * 1024;
constexpr size_t WS_TILEE = WS_MODV + 976 * 1024;
constexpr size_t WS_GQB = WS_MODV + 1000 * 1024;
constexpr size_t WS_TOPI = 2 * MiB, WS_TOPG = 2 * MiB + 320 * 1024, WS_SLOT = 2 * MiB + 640 * 1024;
constexpr size_t WS_STOK = 3 * MiB + 512 * 1024;
constexpr size_t WS_WRT = 3 * MiB;
constexpr size_t WS_WIN = 4 * MiB;
constexpr size_t WS_WBR = 90 * MiB;
constexpr size_t WS_WOUT = 106 * MiB;
constexpr size_t WS_WGU = 114 * MiB;
constexpr size_t WS_WDN = 626 * MiB;
constexpr size_t WS_X = 882 * MiB;
constexpr size_t WS_H = 954 * MiB;
constexpr size_t WS_Z = 990 * MiB;
constexpr size_t WS_RQ = 1377 * MiB, WS_RK = 1395 * MiB, WS_HQ = 1413 * MiB, WS_GQ = 1431 * MiB, WS_GK = 1449 * MiB;
constexpr size_t WS_OS = 1454 * MiB;
constexpr size_t WS_OB = 1598 * MiB;
constexpr size_t WS_SB32 = 1670 * MiB;
constexpr size_t WS_SB = 1742 * MiB;
constexpr size_t WS_HP = 1778 * MiB;
constexpr size_t WS_ACT = 1938 * MiB;
constexpr size_t WS_Y2 = 2098 * MiB;
constexpr size_t WS_YB = 2258 * MiB;
constexpr size_t WS_HLO = 2402 * MiB;
constexpr size_t WS_END = 2438 * MiB;
static_assert(WS_WIN + (size_t)4 * PROJ * 1024 * 2 <= WS_WBR && WS_Z + (size_t)M * PROJ * 2 <= WS_RQ && WS_OS + (size_t)4 * M * 512 * 4 <= WS_OB, "ws map");

constexpr int CW_BAR = 4096;
constexpr int CW_QUEUE = 16384;

constexpr int LDS_BYTES = 147456;
constexpr int MISC_OFF = LDS_BYTES - 512;

__device__ __forceinline__ float bf2f(unsigned v) { return __uint_as_float(v << 16); }
typedef __bf16 hwbf2 __attribute__((ext_vector_type(2)));
typedef float f32x2_ __attribute__((ext_vector_type(2)));
__device__ __forceinline__ unsigned pk2(float lo, float hi) { const f32x2_ v = {lo, hi}; return __builtin_bit_cast(unsigned, __builtin_convertvector(v, hwbf2)); }
__device__ __forceinline__ unsigned f2bf(float f) { return pk2(f, 0.f) & 0xffffu; }
__device__ __forceinline__ float sigmoidf_(float x) { return 1.0f / (1.0f + __expf(-x)); }
__device__ __forceinline__ float siluf_(float x) { return x / (1.0f + __expf(-x)); }
__device__ __forceinline__ void unpack8(u32x4 r, float (&v)[8]) {
    v[0] = bf2f(r.x & 0xffffu); v[1] = bf2f(r.x >> 16); v[2] = bf2f(r.y & 0xffffu); v[3] = bf2f(r.y >> 16);
    v[4] = bf2f(r.z & 0xffffu); v[5] = bf2f(r.z >> 16); v[6] = bf2f(r.w & 0xffffu); v[7] = bf2f(r.w >> 16);
}
__device__ __forceinline__ u32x4 pack8(const float (&v)[8]) { u32x4 r; r.x = pk2(v[0], v[1]); r.y = pk2(v[2], v[3]); r.z = pk2(v[4], v[5]); r.w = pk2(v[6], v[7]); return r; }
__device__ __forceinline__ int shx(int v, int m, int lane) { return __builtin_amdgcn_ds_bpermute((lane ^ m) << 2, v); }
__device__ __forceinline__ unsigned shx(unsigned v, int m, int lane) { return (unsigned)__builtin_amdgcn_ds_bpermute((lane ^ m) << 2, (int)v); }
__device__ __forceinline__ float shx(float v, int m, int lane) { return __int_as_float(__builtin_amdgcn_ds_bpermute((lane ^ m) << 2, __float_as_int(v))); }
__device__ __forceinline__ float wave_sum(float v, int lane) {
#pragma unroll
    for (int o = 1; o < 64; o <<= 1) v += shx(v, o, lane);
    return v;
}
#define LDS_FENCE() asm volatile("s_waitcnt lgkmcnt(0)" ::: "memory")

template <int NK>
__device__ __forceinline__ f32x4 mma16(const LAS bf16* A, int lda, const LAS bf16* Bt, int ldb, f32x4 acc, int lane) {
    const int r = lane & 15, q = lane >> 4;
    const LAS bf16* pa = A + r * lda + 8 * q; const LAS bf16* pb = Bt + r * ldb + 8 * q;
#pragma unroll
    for (int k = 0; k < NK; ++k) {
        const bf16x8 a = *(const LAS bf16x8*)(pa + 32 * k); const bf16x8 b = *(const LAS bf16x8*)(pb + 32 * k);
        acc = __builtin_amdgcn_mfma_f32_16x16x32_bf16(a, b, acc, 0, 0, 0);
    }
    return acc;
}

struct Params { const float* in[25]; float* out; unsigned char* ws; int ph_lo, ph_hi; };
constexpr int PT_OFF = MISC_OFF + 64, PT_OUT = 25, PT_WS = 26;
__device__ __forceinline__ unsigned long long ld_ptr_bits(const LAS unsigned char* lds, int i) {
    unsigned a_ = (unsigned)(size_t)(lds + PT_OFF) + 8u * (unsigned)i; asm volatile("" : "+s"(a_));
    const LAS unsigned* t = (const LAS unsigned*)(size_t)a_;
    const unsigned lo = (unsigned)__builtin_amdgcn_readfirstlane((int)t[0]), hi = (unsigned)__builtin_amdgcn_readfirstlane((int)t[1]);
    return ((unsigned long long)hi << 32) | lo;
}
struct PView {
    const LAS unsigned char* lds; unsigned char* ws; float* out;
    __device__ __forceinline__ PView(const LAS unsigned char* l) : lds(l) { ws = (unsigned char*)(__attribute__((address_space(1))) unsigned char*)ld_ptr_bits(l, PT_WS); out = (float*)(__attribute__((address_space(1))) float*)ld_ptr_bits(l, PT_OUT); }
    __device__ __forceinline__ const float* in(int i) const { return (const float*)(const __attribute__((address_space(1))) float*)ld_ptr_bits(lds, i); }
};
__device__ __forceinline__ int fresh_tid() { int t = threadIdx.x; asm volatile("" : "+v"(t)); return t; }
__device__ __forceinline__ int fresh_blk() { int t = blockIdx.x; asm volatile("" : "+s"(t)); return t; }
__device__ __forceinline__ int fresh_grid() { int t = gridDim.x; asm volatile("" : "+s"(t)); return t; }

namespace pg8 {
struct EpiZ {
    static constexpr bool PERM = true, AFTER_DRAIN = false;
    bf16_t* O; int ldc; const float* ropeA;
    __device__ __forceinline__ void operator()(const f32x4 (&acc)[2][2][4][2], const Unit& u, int wr, int wc, int fr, int fq) const {
        const int row0 = u.pm * BM + wr * 64 + fr, col0 = u.pn * BM + wc * 32 + 8 * fq;
        const bool ret = u.pn < 4, rot = ret && (u.pm < 64);
        const float ksc = (u.pn >= 2 && ret) ? 0.08838834764831845f : 1.0f;
#pragma unroll
        for (int ai = 0; ai < 2; ++ai)
#pragma unroll
            for (int m = 0; m < 4; ++m) { const int row = row0 + ai * HALF + m * 16; bf16_t* rowp = O + (size_t)row * ldc + col0;
                const int t = row & 2047, prow = t >> 6, pcol = t & 63;
#pragma unroll
                for (int bj = 0; bj < 2; ++bj) { f32x4 v0 = acc[ai][bj][m][0], v1 = acc[ai][bj][m][1];
                    if (rot) { const int g8 = ((col0 + bj * HALF) & 127) >> 3; const int pos = (g8 >> 3) ? pcol : prow;
                        const float* tb = ropeA + (pos * 32 + 4 * (g8 & 7)) * 2; const f32x4 t0 = *(const f32x4*)tb, t1 = *(const f32x4*)(tb + 4);
                        const f32x4 cs = (f32x4){t0[0], t0[2], t1[0], t1[2]}, sn = (f32x4){t0[1], t0[3], t1[1], t1[3]};
                        const f32x4 x1 = v0, x2 = v1; v0 = x1 * cs - x2 * sn; v1 = x1 * sn + x2 * cs; }
                    if (ret) { v0 = v0 * ksc; v1 = v1 * ksc; }
                    u32x4 w; w.x = cvt_pk_bf16(v0[0], v0[1]); w.y = cvt_pk_bf16(v0[2], v0[3]); w.z = cvt_pk_bf16(v1[0], v1[1]); w.w = cvt_pk_bf16(v1[2], v1[3]);
                    *(u32x4*)(rowp + bj * HALF) = w; } }
    }
};
struct EpiBranch {
    static constexpr bool PERM = true, AFTER_DRAIN = false;
    bf16_t* YB;
    __device__ __forceinline__ void operator()(const f32x4 (&acc)[2][2][4][2], const Unit& u, int wr, int wc, int fr, int fq) const {
        const int n = u.pn >> 2, pnl = u.pn & 3, pml = u.pm - 72 * n;
        const int row0 = pml * BM + wr * 64 + fr, col0 = pnl * BM + wc * 32 + 8 * fq;
        bf16_t* yb = YB + (size_t)n * 18432 * 1024;
#pragma unroll
        for (int ai = 0; ai < 2; ++ai)
#pragma unroll
            for (int m = 0; m < 4; ++m) { bf16_t* rowp = yb + (size_t)(row0 + ai * HALF + m * 16) * 1024 + col0;
#pragma unroll
                for (int bj = 0; bj < 2; ++bj) { const f32x4 v0 = acc[ai][bj][m][0], v1 = acc[ai][bj][m][1];
                    u32x4 w; w.x = cvt_pk_bf16(v0[0], v0[1]); w.y = cvt_pk_bf16(v0[2], v0[3]); w.z = cvt_pk_bf16(v1[0], v1[1]); w.w = cvt_pk_bf16(v1[2], v1[3]);
                    *(u32x4*)(rowp + bj * HALF) = w; } }
    }
};
struct EpiOut {
    static constexpr bool PERM = true, AFTER_DRAIN = false;
    bf16_t* X; const float* modl; bf16_t* Xo;
    __device__ __forceinline__ void operator()(const f32x4 (&acc)[2][2][4][2], const Unit& u, int wr, int wc, int fr, int fq) const {
        const int row0 = u.pm * BM + wr * 64 + fr, col0 = u.pn * BM + wc * 32 + 8 * fq;
        const int s = (u.pm < 64) ? (u.pm >> 3) : 8;
        const float* g1 = modl + s * 6144 + 2048;
#pragma unroll
        for (int bj = 0; bj < 2; ++bj) { const f32x4 g0 = *(const f32x4*)(g1 + col0 + bj * HALF), g4 = *(const f32x4*)(g1 + col0 + bj * HALF + 4);
#pragma unroll
            for (int ai = 0; ai < 2; ++ai)
#pragma unroll
                for (int m = 0; m < 4; ++m) { const size_t o_ = (size_t)(row0 + ai * HALF + m * 16) * 1024 + col0 + bj * HALF;
                    const u32x4 xr = *(const u32x4*)(X + o_);
                    const f32x4 x0 = (f32x4){__uint_as_float(xr.x << 16), __uint_as_float(xr.x & 0xffff0000u), __uint_as_float(xr.y << 16), __uint_as_float(xr.y & 0xffff0000u)};
                    const f32x4 x1 = (f32x4){__uint_as_float(xr.z << 16), __uint_as_float(xr.z & 0xffff0000u), __uint_as_float(xr.w << 16), __uint_as_float(xr.w & 0xffff0000u)};
                    const f32x4 v0 = x0 * DN_ALPHA + g0 * acc[ai][bj][m][0], v1 = x1 * DN_ALPHA + g4 * acc[ai][bj][m][1];
                    u32x4 w; w.x = cvt_pk_bf16(v0[0], v0[1]); w.y = cvt_pk_bf16(v0[2], v0[3]); w.z = cvt_pk_bf16(v1[0], v1[1]); w.w = cvt_pk_bf16(v1[2], v1[3]);
                    *(u32x4*)(Xo + o_) = w; }
            asm volatile("" ::: "memory"); }
    }
};
struct EpiGU {
    static constexpr bool PERM = true, AFTER_DRAIN = false;
    bf16_t* ACT; const float* bgu;
    __device__ __forceinline__ void operator()(const f32x4 (&acc)[2][2][4][2], const Unit& u, int wr, int wc, int fr, int fq) const {
        const int e = u.pn >> 3, pnl = u.pn & 7;
        const int row0 = u.pm * BM + wr * 64 + fr, cin = wc * 32 + 8 * fq;
        const float* bg = bgu + e * 2048 + 128 * pnl + cin; const float* bu = bg + 1024;
        const f32x4 bg0 = *(const f32x4*)bg, bg1 = *(const f32x4*)(bg + 4), bu0 = *(const f32x4*)bu, bu1 = *(const f32x4*)(bu + 4);
#pragma unroll
        for (int ai = 0; ai < 2; ++ai)
#pragma unroll
            for (int m = 0; m < 4; ++m) { const int row = row0 + ai * HALF + m * 16;
                f32x4 g0 = acc[ai][0][m][0] + bg0, g1 = acc[ai][0][m][1] + bg1, u0 = acc[ai][1][m][0] + bu0, u1 = acc[ai][1][m][1] + bu1;
                f32x4 a0, a1;
#pragma unroll
                for (int j = 0; j < 4; ++j) {
                    float gg = fminf(g0[j], 7.0f), uu = fminf(fmaxf(u0[j], -7.0f), 7.0f); a0[j] = gg / (1.0f + __expf(-1.702f * gg)) * (uu + 1.0f);
                    gg = fminf(g1[j], 7.0f); uu = fminf(fmaxf(u1[j], -7.0f), 7.0f); a1[j] = gg / (1.0f + __expf(-1.702f * gg)) * (uu + 1.0f); }
                u32x4 w; w.x = cvt_pk_bf16(a0[0], a0[1]); w.y = cvt_pk_bf16(a0[2], a0[3]); w.z = cvt_pk_bf16(a1[0], a1[1]); w.w = cvt_pk_bf16(a1[2], a1[3]);
                *(u32x4*)(ACT + (size_t)row * 1024 + 128 * pnl + cin) = w; }
    }
};
struct EpiDown {
    static constexpr bool PERM = true, AFTER_DRAIN = false;
    bf16_t* Y2; const float* bdn;
    __device__ __forceinline__ void operator()(const f32x4 (&acc)[2][2][4][2], const Unit& u, int wr, int wc, int fr, int fq) const {
        const int e = u.pn >> 2, pnl = u.pn & 3;
        const int row0 = u.pm * BM + wr * 64 + fr, col0 = pnl * BM + wc * 32 + 8 * fq;
        f32x4 bv[2][2];
#pragma unroll
        for (int bj = 0; bj < 2; ++bj)
#pragma unroll
            for (int n = 0; n < 2; ++n) bv[bj][n] = *(const f32x4*)(bdn + e * 1024 + col0 + bj * HALF + 4 * n);
#pragma unroll
        for (int ai = 0; ai < 2; ++ai)
#pragma unroll
            for (int m = 0; m < 4; ++m) { bf16_t* rowp = Y2 + (size_t)(row0 + ai * HALF + m * 16) * 1024 + col0;
#pragma unroll
                for (int bj = 0; bj < 2; ++bj) { const f32x4 v0 = acc[ai][bj][m][0] + bv[bj][0], v1 = acc[ai][bj][m][1] + bv[bj][1];
                    u32x4 w; w.x = cvt_pk_bf16(v0[0], v0[1]); w.y = cvt_pk_bf16(v0[2], v0[3]); w.z = cvt_pk_bf16(v1[0], v1[1]); w.w = cvt_pk_bf16(v1[2], v1[3]);
                    *(u32x4*)(rowp + bj * HALF) = w; } }
    }
};
constexpr int INPROJ_DEFER = 24;
struct InProjOrder {
    StaticOrder so; int G, c;
    __device__ void init(int G_, int c_) { so.init(M, 42 * BM, G_, c_); G = G_; c = c_; }
    __device__ bool next(int i, Unit& u) const {
        if (so.next(i, u)) return true;
        const int L = i * G + c - 72 * 42;
        if (L >= 0 && L < 72 - INPROJ_DEFER) { u.pm = INPROJ_DEFER + L; u.pn = 42; return true; }
        return false;
    }
    __device__ __forceinline__ void a_ready(const Unit&) const {}
    __device__ __forceinline__ void done(const Unit&) const {}
};
struct SingleUnit {
    int pm, pn;
    __device__ bool next(int i, Unit& u) const { if (i) return false; u.pm = pm; u.pn = pn; return true; }
    __device__ __forceinline__ void a_ready(const Unit&) const {}
    __device__ __forceinline__ void done(const Unit&) const {}
};
struct BranchOrder {
    int G, c, nunits;
    __device__ bool next(int i, Unit& u) const {
        const int np = nunits >> 4, x = c & 7, rank = c >> 3, nb = G >> 3;
        const int p0 = (x * np) >> 3, p1 = ((x + 1) * np) >> 3, v = i * nb + rank;
        if (v >= (p1 - p0) * 16) return false;
        const int pml = p0 + (v >> 4), n = (v >> 2) & 3, pnl = v & 3;
        u.pm = n * 72 + pml; u.pn = n * 4 + pnl; return true;
    }
    __device__ __forceinline__ void a_ready(const Unit&) const {}
    __device__ __forceinline__ void done(const Unit&) const {}
};
template <int NP> struct MoeOrder {
    int G, c; const int* tile_e;
    __device__ bool next(int i, Unit& u) const {
        const int nt = __builtin_amdgcn_readfirstlane(tile_e[320]);
        const int x = c & 7, rank = c >> 3, nb = G >> 3;
        const int t0 = (x * nt) >> 3, t1 = ((x + 1) * nt) >> 3, v = i * nb + rank;
        if (v >= (t1 - t0) * NP) return false;
        const int t = t0 + v / NP; u.pm = t; u.pn = __builtin_amdgcn_readfirstlane(tile_e[t]) * NP + (v % NP); return true;
    }
    __device__ __forceinline__ void a_ready(const Unit&) const {}
    __device__ __forceinline__ void done(const Unit&) const {}
};
}

__device__ __forceinline__ int ret_perm_row(int n) {
    const int head = n >> 7, dd = n & 127, half = dd >> 6, r = dd & 63, part = r >> 5, i = r & 31;
    return (head << 7) + (((half << 3) + (i >> 2)) << 3) + (part << 2) + (i & 3);
}
__device__ __forceinline__ void p0_transpose_item(const float* W, int K, int N, bf16* WT, int k0, int n0, int dst_row0, LAS float* scr, int lane, bool perm = false) {
    const float* src = W + (size_t)k0 * N + n0 + lane;
    float v[64];
#pragma unroll
    for (int i = 0; i < 64; ++i) v[i] = __builtin_nontemporal_load(src + (size_t)i * N);
#pragma unroll
    for (int i = 0; i < 64; ++i) scr[i * 65 + lane] = v[i];
    LDS_FENCE();
    const int c = lane & 7, nn = lane >> 3;
#pragma unroll
    for (int j = 0; j < 8; ++j) { const int n = nn + 8 * j; const LAS float* s = scr + (8 * c) * 65 + n;
        u32x4 o; o.x = pk2(s[0 * 65], s[1 * 65]); o.y = pk2(s[2 * 65], s[3 * 65]); o.z = pk2(s[4 * 65], s[5 * 65]); o.w = pk2(s[6 * 65], s[7 * 65]);
        __builtin_nontemporal_store(o, (u32x4*)(WT + (size_t)(perm ? ret_perm_row(n0 + n) : dst_row0 + n) * K + k0 + 8 * c)); }
    LDS_FENCE();
}

__device__ __forceinline__ void phase_prologue(LAS unsigned char* lds) {
    const PView p(lds);
    const int tid = fresh_tid(), lane = tid & 63, wave = tid >> 6, G = fresh_grid(), blk = fresh_blk();
    unsigned char* ws = p.ws;
    __syncthreads();
    {
        LAS float* sc = (LAS float*)lds;
        LAS float* part = (LAS float*)(lds + 36864);
        float* modv = (float*)(ws + WS_MODV);
        bool have = false;
        for (int it = blk; it < 384; it += G) {
            if (!have) {
                for (int idx = tid; idx < 9 * 1024; idx += 512) { const int s = idx >> 10, k = idx & 1023; const float v = (s < 8) ? p.in(I_C)[s * 1024 + k] : p.in(I_CCTX)[k]; sc[idx] = v / (1.0f + __expf(-v)); }
                have = true; __syncthreads();
            }
            const int l = it / 96, nb = it % 96, n = nb * 64 + lane;
            float a[9];
#pragma unroll
            for (int s = 0; s < 9; ++s) a[s] = 0.f;
            const float* wm = p.in(I_WMOD) + ((size_t)l * 1024 + wave * 128) * 6144 + n;
#pragma unroll 4
            for (int kk = 0; kk < 128; ++kk) { const float wv = wm[(size_t)kk * 6144];
#pragma unroll
                for (int s = 0; s < 9; ++s) a[s] += sc[s * 1024 + wave * 128 + kk] * wv; }
#pragma unroll
            for (int s = 0; s < 9; ++s) part[(wave * 9 + s) * 64 + lane] = a[s];
            __syncthreads();
            for (int idx = tid; idx < 576; idx += 512) { const int s = idx >> 6, ln = idx & 63; float v = p.in(I_BMOD)[l * 6144 + nb * 64 + ln];
#pragma unroll
                for (int w = 0; w < 8; ++w) v += part[(w * 9 + s) * 64 + ln];
                modv[(size_t)(l * 9 + s) * 6144 + nb * 64 + ln] = v; }
            __syncthreads();
        }
        __syncthreads();
    }
    {
        const int gt = blk * 512 + tid;
        if (gt < 1024) {
            const int d = gt >> 9, c = gt & 511; const float* hb = p.in(I_HLB) + d * 2048 + c;
            const float v0 = hb[0], v1 = hb[512], v2 = hb[1024], v3 = hb[1536]; const float mx = fmaxf(fmaxf(v0, v1), fmaxf(v2, v3));
            const float e0 = expf(v0 - mx), e1 = expf(v1 - mx), e2 = expf(v2 - mx), e3 = expf(v3 - mx), inv = 1.0f / (e0 + e1 + e2 + e3);
            float* lo = (float*)(ws + WS_LOWER) + d * 2048 + c;
            lo[0] = 0.f; lo[512] = e1 * inv; lo[1024] = (e1 + e2) * inv; lo[1536] = (e1 + e2 + e3) * inv;
        } else if (gt < 1024 + 2048) {
            const int idx = gt - 1024, pos = idx >> 5, i = idx & 31; const float inv = powf(10000.0f, -(float)(2 * i) / 64.0f), ang = (float)pos * inv;
            float* t = (float*)(ws + WS_ROPEA) + idx * 2; t[0] = cosf(ang); t[1] = sinf(ang);
        } else if (gt < 1024 + 2048 + 1024) {
            const int idx = gt - 3072, pos = idx >> 4, i = idx & 15; const float inv = powf(10000.0f, -(float)(2 * i) / 32.0f), ang = (float)pos * inv;
            float* t = (float*)(ws + WS_ROPEB) + idx * 2; t[0] = cosf(ang); t[1] = sinf(ang);
        } else if (gt < 1024 + 2048 + 1024 + 4) {
            const int ll = gt - 4096; float mq = 0.f, mk = 0.f;
            for (int j = 0; j < 64; ++j) { mq = fmaxf(mq, fabsf(p.in(I_QNG)[ll * 64 + j])); mk = fmaxf(mk, fabsf(p.in(I_KNG)[ll * 64 + j])); }
            ((float*)(ws + WS_GQB))[ll] = 1.02f * 8.0f * mq * mk * 1.4426950408889634f;
        }
    }
    {
        bf16* wrt = (bf16*)(ws + WS_WRT); const float* wr = p.in(I_WR);
        for (int idx = blk * 512 + tid; idx < 4 * 32 * 1024; idx += G * 512) { const int l = idx >> 15, e = (idx >> 10) & 31, k = idx & 1023;
            const float w = wr[((size_t)l * 1024 + k) * 32 + e]; const unsigned hi = f2bf(w); const float lo = w - bf2f(hi);
            wrt[((size_t)(l * 2 + 0) * 32 + e) * 1024 + k] = (bf16)hi; wrt[((size_t)(l * 2 + 1) * 32 + e) * 1024 + k] = (bf16)f2bf(lo); }
    }
    {
        u32x2* X4 = (u32x2*)(ws + WS_X); const f32x4* x4 = (const f32x4*)p.in(I_X); const f32x4* c4 = (const f32x4*)p.in(I_CTX);
        for (size_t i = (size_t)blk * 512 + tid; i < (size_t)M * 256; i += (size_t)G * 512) { const f32x4 v = (i < (size_t)ML * 256) ? x4[i] : c4[i - (size_t)ML * 256];
            u32x2 w; w.x = pk2(v.x, v.y); w.y = pk2(v.z, v.w); X4[i] = w; }
    }
    {
        LAS float* scr = (LAS float*)(lds + wave * 16640);
        const int gw = blk * 8 + wave, NGW = G * 8;
        constexpr int PER_L = 2752 + 512 + 256 + 16384 + 8192;
        for (int it = gw; it < 4 * PER_L; it += NGW) {
            const int l = it / PER_L; int r = it % PER_L;
            if (r < 2752) { const int kb = r / 172, nb = r % 172;
                p0_transpose_item(p.in(I_WIN) + (size_t)l * 1024 * PROJ, 1024, PROJ, (bf16*)(ws + WS_WIN) + (size_t)l * PROJ * 1024, 64 * kb, 64 * nb, 64 * nb, scr, lane, nb < 16); continue; }
            r -= 2752;
            if (r < 512) { const int n = r >> 7, r2 = r & 127, kb = r2 >> 4, nb = r2 & 15;
                p0_transpose_item(p.in(I_WBR) + (size_t)(l * 4 + n) * 512 * 1024, 512, 1024, (bf16*)(ws + WS_WBR) + (size_t)(l * 4 + n) * 1024 * 512, 64 * kb, 64 * nb, 64 * nb, scr, lane); continue; }
            r -= 512;
            if (r < 256) { const int kb = r >> 4, nb = r & 15;
                p0_transpose_item(p.in(I_WOUT) + (size_t)l * 1024 * 1024, 1024, 1024, (bf16*)(ws + WS_WOUT) + (size_t)l * 1024 * 1024, 64 * kb, 64 * nb, 64 * nb, scr, lane); continue; }
            r -= 256;
            if (r < 16384) { const int e = r >> 9, r2 = r & 511, kb = r2 >> 5, nb = r2 & 31, n0 = 64 * nb;
                const int dr = (n0 < 1024) ? ((n0 >> 7) * 256 + (n0 & 127)) : ((((n0 - 1024) >> 7) * 256) + 128 + ((n0 - 1024) & 127));
                p0_transpose_item(p.in(I_WGU) + (size_t)(l * 32 + e) * 1024 * 2048, 1024, 2048, (bf16*)(ws + WS_WGU) + (size_t)(l * 32 + e) * 2048 * 1024, 64 * kb, n0, dr, scr, lane); continue; }
            r -= 16384;
            { const int e = r >> 8, r2 = r & 255, kb = r2 >> 4, nb = r2 & 15;
                p0_transpose_item(p.in(I_WDN) + (size_t)(l * 32 + e) * 1024 * 1024, 1024, 1024, (bf16*)(ws + WS_WDN) + (size_t)(l * 32 + e) * 1024 * 1024, 64 * kb, 64 * nb, 64 * nb, scr, lane); }
        }
    }
}

__device__ __forceinline__ void row_load16(const float* rowp, int lane, f32x4 (&v)[4]) {
    const f32x4* r = (const f32x4*)rowp + lane;
#pragma unroll
    for (int j = 0; j < 4; ++j) v[j] = r[64 * j];
}
__device__ __forceinline__ void row_store16(float* rowp, int lane, const f32x4 (&v)[4]) {
    f32x4* r = (f32x4*)rowp + lane;
#pragma unroll
    for (int j = 0; j < 4; ++j) r[64 * j] = v[j];
}
__device__ __forceinline__ void row_load16b(const bf16* rowp, int lane, f32x4 (&v)[4]) {
    const u32x2* r = (const u32x2*)rowp + lane;
#pragma unroll
    for (int j = 0; j < 4; ++j) { const u32x2 w = r[64 * j]; v[j] = (f32x4){bf2f(w.x & 0xffffu), bf2f(w.x >> 16), bf2f(w.y & 0xffffu), bf2f(w.y >> 16)}; }
}
__device__ __forceinline__ void row_store16b(bf16* rowp, int lane, const f32x4 (&v)[4]) {
    u32x2* r = (u32x2*)rowp + lane;
#pragma unroll
    for (int j = 0; j < 4; ++j) { u32x2 w; w.x = pk2(v[j].x, v[j].y); w.y = pk2(v[j].z, v[j].w); r[64 * j] = w; }
}
__device__ __forceinline__ void row_ln(f32x4 (&v)[4], const float* g, const float* b, int lane) {
    float s = 0.f;
#pragma unroll
    for (int j = 0; j < 4; ++j) s += (v[j].x + v[j].y) + (v[j].z + v[j].w);
    const float mean = wave_sum(s, lane) * (1.f / 1024.f); float s2 = 0.f;
#pragma unroll
    for (int j = 0; j < 4; ++j) { v[j] = v[j] - mean; s2 += (v[j].x * v[j].x + v[j].y * v[j].y) + (v[j].z * v[j].z + v[j].w * v[j].w); }
    const float rstd = 1.f / sqrtf(wave_sum(s2, lane) * (1.f / 1024.f) + LN_EPS);
#pragma unroll
    for (int j = 0; j < 4; ++j) { const f32x4 gg = *((const f32x4*)g + lane + 64 * j), bb = *((const f32x4*)b + lane + 64 * j); v[j] = v[j] * rstd * gg + bb; }
}
__device__ __forceinline__ void row_mod_store(const f32x4 (&v)[4], const float* sh, const float* sc, bf16* hrow, int lane, f32x4 (&hv)[4]) {
#pragma unroll
    for (int j = 0; j < 4; ++j) { const f32x4 a = *((const f32x4*)sc + lane + 64 * j), c = *((const f32x4*)sh + lane + 64 * j);
        hv[j] = v[j] * (a + 1.0f) + c;
        u32x2 w; w.x = pk2(hv[j].x, hv[j].y); w.y = pk2(hv[j].z, hv[j].w);
        *((u32x2*)hrow + lane + 64 * j) = w; }
}
__device__ __forceinline__ void row_mod_store2(const f32x4 (&v)[4], const float* sh, const float* sc, bf16* hrow, bf16* lrow, int lane) {
#pragma unroll
    for (int j = 0; j < 4; ++j) { const f32x4 a = *((const f32x4*)sc + lane + 64 * j), c = *((const f32x4*)sh + lane + 64 * j);
        const f32x4 h = v[j] * (a + 1.0f) + c;
        const unsigned h0 = f2bf(h.x), h1 = f2bf(h.y), h2 = f2bf(h.z), h3 = f2bf(h.w);
        u32x2 w; w.x = h0 | (h1 << 16); w.y = h2 | (h3 << 16);
        *((u32x2*)hrow + lane + 64 * j) = w;
        u32x2 wl; wl.x = pk2(h.x - bf2f(h0), h.y - bf2f(h1)); wl.y = pk2(h.z - bf2f(h2), h.w - bf2f(h3));
        *((u32x2*)lrow + lane + 64 * j) = wl; }
}
__device__ __forceinline__ int row_seg(int row) { return row < ML ? (row >> 11) : 8; }

__device__ __forceinline__ void phase_init_h(LAS unsigned char* lds) {
    const PView p(lds); const int tid = fresh_tid();
    const int lane = tid & 63, gw = fresh_blk() * 8 + (tid >> 6), NGW = fresh_grid() * 8;
    const bf16* X = (const bf16*)(p.ws + WS_X); bf16* H = (bf16*)(p.ws + WS_H); const float* modv = (const float*)(p.ws + WS_MODV);
    for (int row = gw; row < M; row += NGW) {
        f32x4 v[4], hv[4]; row_load16b(X + (size_t)row * 1024, lane, v);
        const float* mv = modv + (size_t)row_seg(row) * 6144;
        row_mod_store(v, mv, mv + 1024, H + (size_t)row * 1024, lane, hv);
    }
}

__device__ __forceinline__ void phase_prep(LAS unsigned char* lds, int l) {
    const PView p(lds); const int tid = fresh_tid();
    const int lane = tid & 63, gw = fresh_blk() * 8 + (tid >> 6), NGW = fresh_grid() * 8;
    const bf16* Z = (const bf16*)(p.ws + WS_Z);
    bf16* RQ = (bf16*)(p.ws + WS_RQ); bf16* RK = (bf16*)(p.ws + WS_RK); bf16* HQ = (bf16*)(p.ws + WS_HQ); bf16* GQ = (bf16*)(p.ws + WS_GQ); bf16* GK = (bf16*)(p.ws + WS_GK);
    const float* ropeA = (const float*)(p.ws + WS_ROPEA); const float* ropeB = (const float*)(p.ws + WS_ROPEB);
    const float* qng = p.in(I_QNG) + l * 64; const float* kng = p.in(I_KNG) + l * 64;
    constexpr int R = 3;
    for (int row0 = gw; row0 < M; row0 += R * NGW) {
      u32x4 rawv[R][5];
#pragma unroll
      for (int k = 0; k < R; ++k) { const bf16* Zr = Z + (size_t)min(row0 + k * NGW, M - 1) * PROJ;
          rawv[k][0] = *(const u32x4*)(Zr + C_RQ + 8 * lane); rawv[k][1] = *(const u32x4*)(Zr + C_RK + 8 * lane); rawv[k][2] = *(const u32x4*)(Zr + C_HQ + 8 * lane);
          rawv[k][3] = *(const u32x4*)(Zr + C_GQ + 8 * lane); rawv[k][4] = *(const u32x4*)(Zr + C_GK + 8 * (lane & 15)); }
#pragma unroll
      for (int k = 0; k < R; ++k) { const int row = row0 + k * NGW; if (row >= M) break;
        const bool lat = row < ML; const int t = row & 2047, prow = t >> 6, pcol = t & 63;
#pragma unroll
        for (int which = 1; which < 2; ++which) {
            const u32x4 raw = rawv[k][3 + which];
            float x[8]; unpack8(raw, x);
            float ss = 0.f;
#pragma unroll
            for (int j = 0; j < 8; ++j) ss += x[j] * x[j];
            ss += shx(ss, 1, lane); ss += shx(ss, 2, lane); ss += shx(ss, 4, lane);
            const float rinv = 1.0f / sqrtf(ss * (1.0f / 64.0f) + NORM_EPS);
            const int g = lane & 7; const float* gn = (which ? kng : qng) + 8 * g;
#pragma unroll
            for (int j = 0; j < 8; ++j) x[j] = x[j] * rinv * gn[j];
            float px[8];
#pragma unroll
            for (int j = 0; j < 8; ++j) px[j] = shx(x[j], 2, lane);
            const bool isx1 = ((g >> 1) & 1) == 0; const int pos = (g < 4) ? prow : pcol;
            float o[8];
            if (lat) {
                const float* tb = ropeB + (pos * 16 + 8 * (g & 1)) * 2;
#pragma unroll
                for (int j = 0; j < 8; ++j) { const float cs = tb[2 * j], sn = tb[2 * j + 1]; o[j] = isx1 ? (x[j] * cs - px[j] * sn) : (px[j] * sn + x[j] * cs); }
            } else {
#pragma unroll
                for (int j = 0; j < 8; ++j) o[j] = x[j];
            }
            if (which == 1 && lane < 16) *(u32x4*)(GK + (size_t)row * 128 + 8 * lane) = pack8(o);
        }
    }
      }
}

constexpr int SC_QT = 0, SC_QH = 17408, SC_KT = 34816, SC_KHT = 78336, SC_VT = 96768, SC_P = 115200, SC_SUB = 124416, SC_DL = 126464, SC_END = 126976;
static_assert(SC_END <= MISC_OFF, "scan LDS");

__device__ __forceinline__ int scan_row0(int b, int dir, int n) {
    if (n < 4) return ML + b * 256 + (dir ? 255 - 64 * n : 64 * n);
    return b * 2048 + (dir ? 2047 - 64 * (n - 4) : 64 * (n - 4));
}
__device__ __forceinline__ int scan_row(int b, int dir, int pidx) {
    if (pidx < 256) return ML + b * 256 + (dir ? 255 - pidx : pidx);
    const int t = pidx - 256; return b * 2048 + (dir ? 2047 - t : t);
}

template <int MIX>
__device__ __forceinline__ void scan_item(int l, int sub, LAS unsigned char* lds) {
    const PView p(lds);
    const int tid = fresh_tid(), lane = tid & 63, wave = __builtin_amdgcn_readfirstlane(tid >> 6);
    const int dir = sub & 1, h = (sub >> 1) & 3, b = sub >> 3;
    const bf16* Z = (const bf16*)(p.ws + WS_Z);
    const bf16* Qsrc = Z + (MIX ? C_HQ : C_RQ) + h * 128;
    const int q_ld = PROJ;
    const bf16* Ksrc = MIX ? (Z + C_HF + dir * 512 + h * 128) : (Z + C_RK + h * 128);
    const int k_ld = PROJ;
    const bf16* Vsrc = Z + (MIX ? C_HI : C_RV) + h * 128;
    bf16* OS = (bf16*)(p.ws + WS_OS) + (size_t)(MIX * 2 + dir) * M * 512 + h * 128;
    const bool incl = MIX ? true : (dir == 0);

    LAS bf16* Qt = (LAS bf16*)(lds + SC_QT); LAS bf16* Qh = (LAS bf16*)(lds + SC_QH); LAS bf16* Kt = (LAS bf16*)(lds + SC_KT);
    LAS bf16* KhT = (LAS bf16*)(lds + SC_KHT); LAS bf16* VT = (LAS bf16*)(lds + SC_VT); LAS bf16* P = (LAS bf16*)(lds + SC_P);
    LAS float* subt = (LAS float*)(lds + SC_SUB); LAS float* dl = (LAS float*)(lds + SC_DL);

    const int d = tid & 127, I = tid >> 7;
    float lbv = 0.f, lgv = 0.f;
    if (MIX) lbv = ((const float*)(p.ws + WS_LOWER))[dir * 2048 + l * 512 + h * 128 + d];
    else { const float dz = p.in(I_RDEC)[l * 8 + dir * 4 + h]; lgv = fminf(dz, 0.f) - log1pf(__expf(-fabsf(dz))); }

    for (int i = tid; i < (9216 / 4); i += 512) ((LAS unsigned*)P)[i] = 0u;
    if (!MIX && tid < 65) dl[tid] = __builtin_amdgcn_exp2f((float)tid * lgv * 1.4426950408889634f);
    f32x4 sacc[8];
#pragma unroll
    for (int i = 0; i < 8; ++i) sacc[i] = (f32x4){0.f, 0.f, 0.f, 0.f};

    const int sj = tid & 63, sseg = tid >> 6;
    u32x4 pq0, pq1, pk0, pk1, pv0, pv1;
#define SCAN_LOAD_CHUNK(n_) do { const int row_ = scan_row0(b, dir, (n_)) + rstep * sj; \
        const bf16* q_ = Qsrc + (size_t)row_ * q_ld + 16 * sseg; pq0 = *(const u32x4*)q_; pq1 = *(const u32x4*)(q_ + 8); \
        const bf16* k_ = Ksrc + (size_t)row_ * k_ld + 16 * sseg; pk0 = *(const u32x4*)k_; pk1 = *(const u32x4*)(k_ + 8); \
        const bf16* v_ = Vsrc + (size_t)row_ * PROJ + 16 * sseg; pv0 = *(const u32x4*)v_; pv1 = *(const u32x4*)(v_ + 8); } while (0)
    const int rstep = dir ? -1 : 1;
    SCAN_LOAD_CHUNK(0);
    __syncthreads();
    const int r16 = lane & 15, q4 = lane >> 4;

    if constexpr (MIX == 0) {
    for (int n = 0; n < 36; ++n) {
        const int orow0 = scan_row0(b, dir, n);
        *(LAS u32x4*)(Qt + sj * 136 + 16 * sseg) = pq0; *(LAS u32x4*)(Qt + sj * 136 + 16 * sseg + 8) = pq1;
        *(LAS u32x4*)(Qh + sj * 136 + 16 * sseg) = pk0; *(LAS u32x4*)(Qh + sj * 136 + 16 * sseg + 8) = pk1;
        { const float g = dl[63 - sj]; float kv[8]; LAS bf16* kt = KhT + (16 * sseg) * 72 + sj;
          unpack8(pk0, kv);
#pragma unroll
          for (int i = 0; i < 8; ++i) kt[i * 72] = (bf16)f2bf(kv[i] * g);
          unpack8(pk1, kv);
#pragma unroll
          for (int i = 0; i < 8; ++i) kt[(8 + i) * 72] = (bf16)f2bf(kv[i] * g); }
        { LAS bf16* vt = VT + (16 * sseg) * 72 + sj;
          vt[0] = (bf16)(pv0.x & 0xffffu); vt[72] = (bf16)(pv0.x >> 16); vt[144] = (bf16)(pv0.y & 0xffffu); vt[216] = (bf16)(pv0.y >> 16);
          vt[288] = (bf16)(pv0.z & 0xffffu); vt[360] = (bf16)(pv0.z >> 16); vt[432] = (bf16)(pv0.w & 0xffffu); vt[504] = (bf16)(pv0.w >> 16);
          vt[576] = (bf16)(pv1.x & 0xffffu); vt[648] = (bf16)(pv1.x >> 16); vt[720] = (bf16)(pv1.y & 0xffffu); vt[792] = (bf16)(pv1.y >> 16);
          vt[864] = (bf16)(pv1.z & 0xffffu); vt[936] = (bf16)(pv1.z >> 16); vt[1008] = (bf16)(pv1.w & 0xffffu); vt[1080] = (bf16)(pv1.w >> 16); }
        if (n + 1 < 36) SCAN_LOAD_CHUNK(n + 1);
        __syncthreads();
#pragma unroll
        for (int rep = 0; rep < 2; ++rep) {
            const int tIdx = wave + 8 * rep;
            if (tIdx < 10) {
                const int Ip = (tIdx < 1) ? 0 : (tIdx < 3) ? 1 : (tIdx < 6) ? 2 : 3;
                const int J = tIdx - ((Ip * (Ip + 1)) >> 1);
                f32x4 a = (f32x4){0.f, 0.f, 0.f, 0.f};
                a = mma16<4>(Qt + (16 * Ip) * 136, 136, Qh + (16 * J) * 136, 136, a, lane);
#pragma unroll
                for (int r = 0; r < 4; ++r) {
                    const int dij = 16 * (Ip - J) + 4 * q4 + r - r16;
                    const bool keep = incl ? (dij >= 0) : (dij > 0);
                    const float v = keep ? a[r] * dl[max(dij, 0)] : 0.f;
                    P[(16 * Ip + 4 * q4 + r) * 72 + 16 * J + r16] = (bf16)f2bf(v);
                }
            }
        }
        bf16x8 sfr[4];
#pragma unroll
        for (int ks = 0; ks < 4; ++ks) { u32x4 w; w.x = pk2(sacc[2 * ks][0], sacc[2 * ks][1]); w.y = pk2(sacc[2 * ks][2], sacc[2 * ks][3]); w.z = pk2(sacc[2 * ks + 1][0], sacc[2 * ks + 1][1]); w.w = pk2(sacc[2 * ks + 1][2], sacc[2 * ks + 1][3]);
            sfr[ks] = __builtin_bit_cast(bf16x8, w); }
        __syncthreads();
#pragma unroll
        for (int it = 0; it < 4; ++it) {
            f32x4 o = (f32x4){0.f, 0.f, 0.f, 0.f}, ox = o;
            o = mma16<2>(VT + (16 * wave) * 72, 72, P + (16 * it) * 72, 72, o, lane);
            const LAS bf16* qh = Qt + (16 * it + r16) * 136 + 4 * q4;
#pragma unroll
            for (int ks = 0; ks < 4; ++ks) {
                const u32x2 a0 = *(const LAS u32x2*)(qh + 32 * ks), a1 = *(const LAS u32x2*)(qh + 32 * ks + 16);
                u32x4 aw; aw.x = a0.x; aw.y = a0.y; aw.z = a1.x; aw.w = a1.y;
                ox = __builtin_amdgcn_mfma_f32_16x16x32_bf16(sfr[ks], __builtin_bit_cast(bf16x8, aw), ox, 0, 0, 0);
            }
            { const int i = 16 * it + r16; const float gi = dl[i + 1];
              u32x2 w; w.x = pk2(o[0] + gi * ox[0], o[1] + gi * ox[1]); w.y = pk2(o[2] + gi * ox[2], o[3] + gi * ox[3]);
              *(u32x2*)(OS + (size_t)(orow0 + rstep * i) * 512 + 16 * wave + 4 * q4) = w; }
        }
        { const float g64 = dl[64];
#pragma unroll
          for (int dt = 0; dt < 8; ++dt) sacc[dt] = mma16<2>(KhT + (16 * dt) * 72, 72, VT + (16 * wave) * 72, 72, sacc[dt] * g64, lane); }
        __syncthreads();
    }
    } else {
    for (int n = 0; n < 36; ++n) {
        const int orow0 = scan_row0(b, dir, n);
        *(LAS u32x4*)(Qt + sj * 136 + 16 * sseg) = pq0; *(LAS u32x4*)(Qt + sj * 136 + 16 * sseg + 8) = pq1;
        *(LAS u32x4*)(Qh + sj * 136 + 16 * sseg) = pk0; *(LAS u32x4*)(Qh + sj * 136 + 16 * sseg + 8) = pk1;
        { LAS bf16* vt = VT + (16 * sseg) * 72 + sj;
          vt[0] = (bf16)(pv0.x & 0xffffu); vt[72] = (bf16)(pv0.x >> 16); vt[144] = (bf16)(pv0.y & 0xffffu); vt[216] = (bf16)(pv0.y >> 16);
          vt[288] = (bf16)(pv0.z & 0xffffu); vt[360] = (bf16)(pv0.z >> 16); vt[432] = (bf16)(pv0.w & 0xffffu); vt[504] = (bf16)(pv0.w >> 16);
          vt[576] = (bf16)(pv1.x & 0xffffu); vt[648] = (bf16)(pv1.x >> 16); vt[720] = (bf16)(pv1.y & 0xffffu); vt[792] = (bf16)(pv1.y >> 16);
          vt[864] = (bf16)(pv1.z & 0xffffu); vt[936] = (bf16)(pv1.z >> 16); vt[1008] = (bf16)(pv1.w & 0xffffu); vt[1080] = (bf16)(pv1.w >> 16); }
        if (n + 1 < 36) SCAN_LOAD_CHUNK(n + 1);
        __syncthreads();
        float c[16], q[16], key[16];
        {
            float run = 0.f;
#pragma unroll
            for (int jj = 0; jj < 16; ++jj) {
                q[jj] = bf2f(Qt[(16 * I + jj) * 136 + d]);
                const float kr = bf2f(Qh[(16 * I + jj) * 136 + d]);
                float lf;
                if (MIX) { q[jj] = siluf_(q[jj]); const float ez = __expf(-fminf(fmaxf(kr, -30.f), 30.f));
                    const float sg = 1.0f / (1.0f + ez); const float f = lbv + (1.0f - lbv) * sg;
                    lf = __logf(f); key[jj] = (1.0f - lbv) * (ez * sg); }
                else { lf = lgv; key[jj] = kr; }
                run += lf; c[jj] = run;
            }
            subt[I * 128 + d] = run;
        }
        __syncthreads();
        {
            const float t0 = subt[d], t1 = subt[128 + d], t2 = subt[256 + d], t3 = subt[384 + d];
            const float ref1 = t0, ref2 = t0 + t1, ref3 = ref2 + t2, tot = ref3 + t3;
            const float pre = (I == 0) ? 0.f : (I == 1) ? ref1 : (I == 2) ? ref2 : ref3;
            if (I == 0) dl[d] = __expf(tot);
            const float Epre = __expf(pre), Etp = __expf(tot - pre);
            const float Er1 = __expf(ref1 - pre), Er2 = __expf(ref2 - pre), Er3 = __expf(ref3 - pre);
            unsigned khp[8];
#pragma unroll
            for (int jj = 0; jj < 16; ++jj) {
                const int j = 16 * I + jj;
                const float qt = q[jj] * __expf(c[jj]);
                const float kd = key[jj] * __expf(fminf(-c[jj], 80.f));
                Qt[j * 136 + d] = (bf16)f2bf(qt);
                Qh[j * 136 + d] = (bf16)f2bf(qt * Epre);
                const unsigned khb = f2bf(kd * Etp);
                if (jj & 1) khp[jj >> 1] |= khb << 16; else khp[jj >> 1] = khb;
                Kt[(((I == 0) ? 0 : (I == 1) ? 16 : (I == 2) ? 48 : 96) + j) * 136 + d] = (bf16)f2bf(kd);
                if (I < 1) Kt[(16 + j) * 136 + d] = (bf16)f2bf(kd * Er1);
                if (I < 2) Kt[(48 + j) * 136 + d] = (bf16)f2bf(kd * Er2);
                if (I < 3) Kt[(96 + j) * 136 + d] = (bf16)f2bf(kd * Er3);
            }
            u32x4 w0, w1;
            w0.x = khp[0]; w0.y = khp[1]; w0.z = khp[2]; w0.w = khp[3]; w1.x = khp[4]; w1.y = khp[5]; w1.z = khp[6]; w1.w = khp[7];
            *(LAS u32x4*)(KhT + d * 72 + 16 * I) = w0; *(LAS u32x4*)(KhT + d * 72 + 16 * I + 8) = w1;
        }
        __syncthreads();
#pragma unroll
        for (int rep = 0; rep < 2; ++rep) {
            const int tIdx = wave + 8 * rep;
            if (tIdx < 10) {
                const int Ip = (tIdx < 1) ? 0 : (tIdx < 3) ? 1 : (tIdx < 6) ? 2 : 3;
                const int J = tIdx - ((Ip * (Ip + 1)) >> 1);
                const int kbase = (Ip == 0) ? 0 : (Ip == 1) ? 16 : (Ip == 2) ? 48 : 96;
                f32x4 a = (f32x4){0.f, 0.f, 0.f, 0.f};
                a = mma16<4>(Qt + (16 * Ip) * 136, 136, Kt + (kbase + 16 * J) * 136, 136, a, lane);
                const int jc = lane & 15, iq = 4 * (lane >> 4);
#pragma unroll
                for (int r = 0; r < 4; ++r) {
                    float v = a[r];
                    if (J == Ip) { const bool keep = incl ? (jc <= iq + r) : (jc < iq + r); v = keep ? v : 0.f; }
                    P[(16 * Ip + iq + r) * 72 + 16 * J + jc] = (bf16)f2bf(v);
                }
            }
        }
        bf16x8 sfr[4];
#pragma unroll
        for (int ks = 0; ks < 4; ++ks) { u32x4 w; w.x = pk2(sacc[2 * ks][0], sacc[2 * ks][1]); w.y = pk2(sacc[2 * ks][2], sacc[2 * ks][3]); w.z = pk2(sacc[2 * ks + 1][0], sacc[2 * ks + 1][1]); w.w = pk2(sacc[2 * ks + 1][2], sacc[2 * ks + 1][3]);
            sfr[ks] = __builtin_bit_cast(bf16x8, w); }
        __syncthreads();
#pragma unroll
        for (int it = 0; it < 4; ++it) {
            f32x4 o = (f32x4){0.f, 0.f, 0.f, 0.f};
            o = mma16<2>(VT + (16 * wave) * 72, 72, P + (16 * it) * 72, 72, o, lane);
            const LAS bf16* qh = Qh + (16 * it + r16) * 136 + 4 * q4;
#pragma unroll
            for (int ks = 0; ks < 4; ++ks) {
                const u32x2 a0 = *(const LAS u32x2*)(qh + 32 * ks), a1 = *(const LAS u32x2*)(qh + 32 * ks + 16);
                u32x4 aw; aw.x = a0.x; aw.y = a0.y; aw.z = a1.x; aw.w = a1.y;
                o = __builtin_amdgcn_mfma_f32_16x16x32_bf16(sfr[ks], __builtin_bit_cast(bf16x8, aw), o, 0, 0, 0);
            }
            { const int i = 16 * it + r16;
              u32x2 w; w.x = pk2(o[0], o[1]); w.y = pk2(o[2], o[3]);
              *(u32x2*)(OS + (size_t)(orow0 + rstep * i) * 512 + 16 * wave + 4 * q4) = w; }
        }
#pragma unroll
        for (int dt = 0; dt < 8; ++dt) {
            const f32x4 dv = *(const LAS f32x4*)(dl + 16 * dt + 4 * q4);
            sacc[dt] = mma16<2>(KhT + (16 * dt) * 72, 72, VT + (16 * wave) * 72, 72, sacc[dt] * dv, lane);
        }
        __syncthreads();
    }
    }
#undef SCAN_LOAD_CHUNK
}

constexpr int AT_Q = 0, AT_K = 36864, AT_V = 55296, AT_RPB = 73728, AT_END = 75776;
typedef short s16x4 __attribute__((ext_vector_type(4)));
template <bool NA>
__device__ __forceinline__ void attn_unit(int l, int kind, int sub, LAS unsigned char* lds) {
    const PView p(lds);
    const int tid = fresh_tid(), lane = tid & 63, wave = __builtin_amdgcn_readfirstlane(tid >> 6);
    const bf16* Z = (const bf16*)(p.ws + WS_Z);
    constexpr bool na = NA; const bool lat = (kind & 1) == 0;
    int b, hh, qt = 0;
    if (lat) { qt = sub & 7; hh = (sub >> 3) & 7; b = sub >> 6; } else { hh = sub & 7; b = sub >> 3; }
    const bf16* Qp; const bf16* Kp; const bf16* Vp; int q_ld, k_ld;
    if (na) { Qp = Z + C_NQ + hh * 64; q_ld = PROJ; Kp = Z + C_NK + hh * 64; k_ld = PROJ; Vp = Z + C_NV + hh * 64; }
    else { Qp = Z + C_GQ + hh * 64; q_ld = PROJ; Kp = (const bf16*)(p.ws + WS_GK) + (hh >> 2) * 64; k_ld = 128; Vp = Z + C_GV + (hh >> 2) * 64; }
    bf16* Op = (bf16*)(p.ws + WS_OB) + (size_t)(na ? 2 : 3) * M * 512 + hh * 64;
    const int q_row0 = lat ? (b * 2048 + 256 * qt) : (ML + b * 256);
    int nloc = 0, lat_row0 = b * 2048, R0 = 0;
    if (lat) { if (na) { const int r0 = 4 * qt, r1 = 4 * qt + 3; R0 = min(max(r0 - 4, 0), 24); nloc = min(max(r1 - 4, 0), 24) + 8 - R0; lat_row0 = b * 2048 + 64 * R0; } else nloc = 32; }
    const int ntile = nloc + 4, ctx_row0 = ML + b * 256;

    LAS bf16* Qs = (LAS bf16*)(lds + AT_Q); LAS bf16* Ks = (LAS bf16*)(lds + AT_K); LAS bf16* Vs = (LAS bf16*)(lds + AT_V); LAS float* rpb = (LAS float*)(lds + AT_RPB);
    constexpr float LOG2E = 1.4426950408889634f;
    const float gq_shift = ((const float*)(p.ws + WS_GQB))[l];

    { const int row = tid >> 1, seg = tid & 1; const bf16* src = Qp + (size_t)(q_row0 + row) * q_ld + 32 * seg;
      u32x4 a0 = *(const u32x4*)src, a1 = *(const u32x4*)(src + 8), a2 = *(const u32x4*)(src + 16), a3 = *(const u32x4*)(src + 24);
      if (!na) {
          float x[32]; { float t8[8]; unpack8(a0, t8);
#pragma unroll
              for (int j = 0; j < 8; ++j) x[j] = t8[j];
              unpack8(a1, t8);
#pragma unroll
              for (int j = 0; j < 8; ++j) x[8 + j] = t8[j];
              unpack8(a2, t8);
#pragma unroll
              for (int j = 0; j < 8; ++j) x[16 + j] = t8[j];
              unpack8(a3, t8);
#pragma unroll
              for (int j = 0; j < 8; ++j) x[24 + j] = t8[j]; }
          float ss = 0.f;
#pragma unroll
          for (int j = 0; j < 32; ++j) ss += x[j] * x[j];
          ss += shx(ss, 1, lane);
          const float rinv = 1.0f / sqrtf(ss * (1.0f / 64.0f) + NORM_EPS);
          const float* gn = p.in(I_QNG) + l * 64 + 32 * seg;
#pragma unroll
          for (int j = 0; j < 32; ++j) x[j] = x[j] * rinv * gn[j];
          if (lat) { const int tq = 256 * qt + row; const int pos = seg ? (tq & 63) : (tq >> 6);
              const float* tb = (const float*)(p.ws + WS_ROPEB) + pos * 32;
#pragma unroll
              for (int j = 0; j < 16; ++j) { const float cs = tb[2 * j], sn = tb[2 * j + 1], x1 = x[j], x2 = x[16 + j]; x[j] = x1 * cs - x2 * sn; x[16 + j] = x1 * sn + x2 * cs; } }
#pragma unroll
          for (int j = 0; j < 32; ++j) x[j] *= 0.125f * LOG2E;
          a0.x = pk2(x[0], x[1]); a0.y = pk2(x[2], x[3]); a0.z = pk2(x[4], x[5]); a0.w = pk2(x[6], x[7]);
          a1.x = pk2(x[8], x[9]); a1.y = pk2(x[10], x[11]); a1.z = pk2(x[12], x[13]); a1.w = pk2(x[14], x[15]);
          a2.x = pk2(x[16], x[17]); a2.y = pk2(x[18], x[19]); a2.z = pk2(x[20], x[21]); a2.w = pk2(x[22], x[23]);
          a3.x = pk2(x[24], x[25]); a3.y = pk2(x[26], x[27]); a3.z = pk2(x[28], x[29]); a3.w = pk2(x[30], x[31]);
      }
      LAS bf16* dst = Qs + row * 72 + 32 * seg;
      *(LAS u32x4*)dst = a0; *(LAS u32x4*)(dst + 8) = a1; *(LAS u32x4*)(dst + 16) = a2; *(LAS u32x4*)(dst + 24) = a3; }
    if (na && lat) { const float* rp = p.in(I_RPB) + (size_t)(l * 8 + hh) * 465; for (int i = tid; i < 465; i += 512) rpb[i] = rp[i] * LOG2E; }

    u32x4 kreg, vreg;
    const int krow = tid >> 3, kseg = tid & 7;
#define ATT_LOAD_TILE(kt_) do { const int row0_ = ((kt_) < nloc) ? (lat_row0 + 64 * (kt_)) : (ctx_row0 + 64 * ((kt_) - nloc)); \
        kreg = *(const u32x4*)(Kp + (size_t)(row0_ + krow) * k_ld + 8 * kseg); vreg = *(const u32x4*)(Vp + (size_t)(row0_ + krow) * PROJ + 8 * kseg); } while (0)
#define ATT_STORE_TILE(buf_) do { *(LAS u32x4*)(Ks + (buf_) * 4608 + krow * 72 + 8 * kseg) = kreg; *(LAS u32x4*)(Vs + (buf_) * 4608 + krow * 72 + 8 * kseg) = vreg; } while (0)
    ATT_LOAD_TILE(0);
    ATT_STORE_TILE(0);
    ATT_LOAD_TILE(1);
    __syncthreads();

    const int r16 = lane & 15, q4 = lane >> 4;
    bf16x8 qf[2][2];
    int w0[2], c0[2], rqv[2], cqv[2];
    float m_run[2], l_run[2];
    f32x4 o[2][4];
#pragma unroll
    for (int c = 0; c < 2; ++c) {
        const int qi = 32 * wave + 16 * c + r16;
        qf[c][0] = *(const LAS bf16x8*)(Qs + qi * 72 + 8 * q4); qf[c][1] = *(const LAS bf16x8*)(Qs + qi * 72 + 32 + 8 * q4);
        rqv[c] = 4 * qt + (qi >> 6); cqv[c] = qi & 63; w0[c] = min(max(rqv[c] - 4, 0), 24); c0[c] = min(max(cqv[c] - 8, 0), 48);
        m_run[c] = -INFINITY; l_run[c] = 0.f;
#pragma unroll
        for (int r = 0; r < 4; ++r) o[c][r] = (f32x4){0.f, 0.f, 0.f, 0.f};
    }
    const int koff = r16 * 72 + 8 * q4;
    const int voff = (4 * q4 + (r16 >> 2)) * 72 + 4 * (r16 & 3);
    const float si_ = na ? 0.f : -gq_shift; const f32x4 sinit = (f32x4){si_, si_, si_, si_};
    const bf16x8 ones = (bf16x8){0x3f80, 0x3f80, 0x3f80, 0x3f80, 0x3f80, 0x3f80, 0x3f80, 0x3f80};
    f32x4 lacc[2] = {(f32x4){0.f, 0.f, 0.f, 0.f}, (f32x4){0.f, 0.f, 0.f, 0.f}};

    for (int kt = 0; kt < ntile; ++kt) {
        const int cur = kt & 1;
        if (kt + 1 < ntile) { ATT_STORE_TILE(cur ^ 1); if (kt + 2 < ntile) ATT_LOAD_TILE(kt + 2); }
        const LAS bf16* Kb = Ks + cur * 4608; const LAS bf16* Vb = Vs + cur * 4608;
        const int w0w = min(max(4 * qt + (wave >> 1) - 4, 0), 24);
        if (!(na && kt < nloc && (R0 + kt < w0w || R0 + kt >= w0w + 8))) {
        f32x4 s[2][4];
#pragma unroll
        for (int jt = 0; jt < 4; ++jt) {
            const bf16x8 k0 = *(const LAS bf16x8*)(Kb + 16 * jt * 72 + koff), k1 = *(const LAS bf16x8*)(Kb + 16 * jt * 72 + koff + 32);
#pragma unroll
            for (int c = 0; c < 2; ++c) {
                s[c][jt] = __builtin_amdgcn_mfma_f32_16x16x32_bf16(k0, qf[c][0], sinit, 0, 0, 0);
                s[c][jt] = __builtin_amdgcn_mfma_f32_16x16x32_bf16(k1, qf[c][1], s[c][jt], 0, 0, 0);
            }
        }
        const bool local = na && (kt < nloc);
        const int kr = R0 + kt;
        bf16x8 pf[2][2];
#pragma unroll
        for (int c = 0; c < 2; ++c) {
            constexpr float SC = 0.125f * LOG2E;
            if (!na) {
#pragma unroll
                for (int jt = 0; jt < 4; ++jt)
#pragma unroll
                    for (int r = 0; r < 4; ++r) s[c][jt][r] = __builtin_amdgcn_exp2f(s[c][jt][r]);
            } else {
            float tm = -INFINITY;
            if (local) {
                const bool rowok = (kr >= w0[c]) && (kr < w0[c] + 8);
#pragma unroll
                for (int jt = 0; jt < 4; ++jt)
#pragma unroll
                    for (int r = 0; r < 4; ++r) {
                        const int kc = 16 * jt + 4 * q4 + r; const bool ok = rowok && (kc >= c0[c]) && (kc < c0[c] + 16);
                        const int bi = min(max((kr - rqv[c] + 7) * 31 + (kc - cqv[c] + 15), 0), 464);
                        const float v = ok ? __builtin_fmaf(s[c][jt][r], SC, rpb[bi]) : -INFINITY;
                        s[c][jt][r] = v; tm = fmaxf(tm, v);
                    }
            } else {
#pragma unroll
                for (int jt = 0; jt < 4; ++jt) tm = fmaxf(fmaxf(tm, fmaxf(s[c][jt][0], s[c][jt][1])), fmaxf(s[c][jt][2], s[c][jt][3]));
                tm *= SC;
            }
            tm = fmaxf(tm, shx(tm, 16, lane)); tm = fmaxf(tm, shx(tm, 32, lane));
            const float mn = fmaxf(m_run[c], tm), mu = (mn == -INFINITY) ? 0.f : mn;
            const float alpha = __builtin_amdgcn_exp2f(m_run[c] - mu);
            float ps = 0.f;
            if (local) {
#pragma unroll
                for (int jt = 0; jt < 4; ++jt)
#pragma unroll
                    for (int r = 0; r < 4; ++r) { const float pv = __builtin_amdgcn_exp2f(s[c][jt][r] - mu); s[c][jt][r] = pv; ps += pv; }
            } else {
#pragma unroll
                for (int jt = 0; jt < 4; ++jt)
#pragma unroll
                    for (int r = 0; r < 4; ++r) { const float pv = __builtin_amdgcn_exp2f(__builtin_fmaf(s[c][jt][r], SC, -mu)); s[c][jt][r] = pv; ps += pv; }
            }
            l_run[c] = l_run[c] * alpha + ps; m_run[c] = mn;
#pragma unroll
            for (int et = 0; et < 4; ++et) o[c][et] = o[c][et] * alpha;
            }
#pragma unroll
            for (int kk = 0; kk < 2; ++kk) { u32x4 w; w.x = pk2(s[c][2 * kk][0], s[c][2 * kk][1]); w.y = pk2(s[c][2 * kk][2], s[c][2 * kk][3]); w.z = pk2(s[c][2 * kk + 1][0], s[c][2 * kk + 1][1]); w.w = pk2(s[c][2 * kk + 1][2], s[c][2 * kk + 1][3]);
                pf[c][kk] = __builtin_bit_cast(bf16x8, w);
                if (!na) lacc[c] = __builtin_amdgcn_mfma_f32_16x16x32_bf16(ones, pf[c][kk], lacc[c], 0, 0, 0); }
        }
#pragma unroll
        for (int et = 0; et < 4; ++et)
#pragma unroll
            for (int kk = 0; kk < 2; ++kk) {
                const s16x4 va = __builtin_amdgcn_ds_read_tr16_b64_v4i16((LAS s16x4*)(Vb + (32 * kk) * 72 + 16 * et + voff));
                const s16x4 vb = __builtin_amdgcn_ds_read_tr16_b64_v4i16((LAS s16x4*)(Vb + (32 * kk + 16) * 72 + 16 * et + voff));
                const bf16x8 vf = __builtin_shufflevector(va, vb, 0, 1, 2, 3, 4, 5, 6, 7);
                o[0][et] = __builtin_amdgcn_mfma_f32_16x16x32_bf16(vf, pf[0][kk], o[0][et], 0, 0, 0);
                o[1][et] = __builtin_amdgcn_mfma_f32_16x16x32_bf16(vf, pf[1][kk], o[1][et], 0, 0, 0);
            }
        }
        __syncthreads();
        __syncthreads();
    }
#undef ATT_LOAD_TILE
#undef ATT_STORE_TILE
#pragma unroll
    for (int c = 0; c < 2; ++c) {
        float lt;
        if (!na) lt = lacc[c][0];
        else { lt = l_run[c]; lt += shx(lt, 16, lane); lt += shx(lt, 32, lane); }
        const float inv = 1.0f / lt;
        bf16* orow = Op + (size_t)(q_row0 + 32 * wave + 16 * c + r16) * 512 + 4 * q4;
#pragma unroll
        for (int et = 0; et < 4; ++et) { u32x2 w; w.x = pk2(o[c][et][0] * inv, o[c][et][1] * inv); w.y = pk2(o[c][et][2] * inv, o[c][et][3] * inv); *(u32x2*)(orow + 16 * et) = w; }
    }
}

constexpr int Q_GL = 512, Q_GC = 64, Q_NL = 512, Q_NC = 64, Q_ATT = Q_GL + Q_GC + Q_NL + Q_NC;
__device__ __forceinline__ int queue_pop(unsigned* head, LAS unsigned char* lds) {
    volatile LAS int* misc = (volatile LAS int*)(lds + MISC_OFF);
    __syncthreads();
    if (threadIdx.x == 0) misc[4] = (int)__hip_atomic_fetch_add(head, 1u, __ATOMIC_RELAXED, __HIP_MEMORY_SCOPE_AGENT);
    __syncthreads();
    return __builtin_amdgcn_readfirstlane(misc[4]);
}
template <int REP_SCAN, int REP_ATT>
__device__ __forceinline__ void phase_mixers(int l, LAS unsigned char* lds, int qoff) {
    unsigned* qhead; { const PView p(lds); qhead = (unsigned*)(p.ws + WS_CTL) + CW_QUEUE + 512 * l + qoff; }
    for (;;) { const int item = queue_pop(qhead + 64, lds); if (item >= 64 * REP_SCAN) break; scan_item<1>(l, item & 63, lds); }
    for (;;) { const int item = queue_pop(qhead, lds); if (item >= 64 * REP_SCAN) break; scan_item<0>(l, item & 63, lds); }
    for (;;) {
        const int item = queue_pop(qhead + 192, lds); if (item >= pg8::INPROJ_DEFER) break;
        const PView pv(lds); unsigned char* ws = pv.ws;
        pg8::Gemm g{(const pg8::bf16_t*)(ws + WS_H), (const pg8::bf16_t*)(ws + WS_WIN) + (size_t)l * PROJ * 1024, M, PROJ, 1024};
        pg8::SingleUnit S{item, 42};
        pg8::EpiZ E{(pg8::bf16_t*)(ws + WS_Z), PROJ, (const float*)(ws + WS_ROPEA)};
        pg8::gemm_phase<pg8::EpiZ, pg8::SingleUnit, true, true>(lds, g, S, E);
    }
    for (;;) {
        int item = queue_pop(qhead + 128, lds); if (item >= (Q_GL + Q_GC) * REP_ATT) break;
        if (REP_ATT > 1) item %= (Q_GL + Q_GC);
        const bool cx = item >= Q_GL; attn_unit<false>(l, cx ? 1 : 0, cx ? item - Q_GL : item, lds);
    }
    for (;;) {
        int item = queue_pop(qhead + 256, lds); if (item >= (Q_NL + Q_NC) * REP_ATT) break;
        if (REP_ATT > 1) item %= (Q_NL + Q_NC);
        const bool cx = item >= Q_NL; attn_unit<true>(l, cx ? 3 : 2, cx ? item - Q_NL : item, lds);
    }
}

__device__ __forceinline__ void phase_postscan(LAS unsigned char* lds, int l) {
    const PView p(lds); const int tid = fresh_tid();
    const int lane = tid & 63, gw = fresh_blk() * 8 + (tid >> 6), NGW = fresh_grid() * 8;
    const bf16* Z = (const bf16*)(p.ws + WS_Z); const bf16* OS = (const bf16*)(p.ws + WS_OS); bf16* OB = (bf16*)(p.ws + WS_OB);
    const float* gng = p.in(I_RGNG) + l * 512 + 8 * lane; const float* gnb = p.in(I_RGNB) + l * 512 + 8 * lane; const float* hng = p.in(I_HNG) + l * 512 + 8 * lane;
    constexpr int R = 3;
    for (int row0 = gw; row0 < M; row0 += R * NGW) {
        u32x4 ld[R][2][2]; u32x4 gr[R][2];
#pragma unroll
        for (int k = 0; k < R; ++k) { const int row = min(row0 + k * NGW, M - 1);
#pragma unroll
            for (int mix = 0; mix < 2; ++mix) {
                const bf16* a = OS + ((size_t)(mix * 2) * M + row) * 512 + 8 * lane;
                ld[k][mix][0] = *(const u32x4*)a; ld[k][mix][1] = *(const u32x4*)(a + (size_t)M * 512);
                gr[k][mix] = *(const u32x4*)(Z + (size_t)row * PROJ + (mix ? C_HG : C_RG) + 8 * lane); } }
#pragma unroll
        for (int k = 0; k < R; ++k) { const int row = row0 + k * NGW;
#pragma unroll
            for (int mix = 0; mix < 2; ++mix) {
                float o[8], ob[8]; unpack8(ld[k][mix][0], o); unpack8(ld[k][mix][1], ob);
#pragma unroll
                for (int j = 0; j < 8; ++j) o[j] += ob[j];
                float g[8]; unpack8(gr[k][mix], g);
                float y[8];
                if (mix == 0) {
                    float s = 0.f;
#pragma unroll
                    for (int j = 0; j < 8; ++j) s += o[j];
                    s += shx(s, 1, lane); s += shx(s, 2, lane); s += shx(s, 4, lane); s += shx(s, 8, lane);
                    const float mu = s * (1.0f / 128.0f); float s2 = 0.f;
#pragma unroll
                    for (int j = 0; j < 8; ++j) { o[j] -= mu; s2 += o[j] * o[j]; }
                    s2 += shx(s2, 1, lane); s2 += shx(s2, 2, lane); s2 += shx(s2, 4, lane); s2 += shx(s2, 8, lane);
                    const float rstd = 1.0f / sqrtf(s2 * (1.0f / 128.0f) + LN_EPS);
#pragma unroll
                    for (int j = 0; j < 8; ++j) y[j] = (o[j] * rstd * gng[j] + gnb[j]) * siluf_(g[j]);
                } else {
                    float s2 = 0.f;
#pragma unroll
                    for (int j = 0; j < 8; ++j) s2 += o[j] * o[j];
                    s2 += shx(s2, 1, lane); s2 += shx(s2, 2, lane); s2 += shx(s2, 4, lane); s2 += shx(s2, 8, lane);
                    const float rinv = 1.0f / sqrtf(s2 * (1.0f / 128.0f) + NORM_EPS);
#pragma unroll
                    for (int j = 0; j < 8; ++j) y[j] = o[j] * rinv * hng[j] * siluf_(g[j]);
                }
                if (row < M) *(u32x4*)(OB + ((size_t)mix * M + row) * 512 + 8 * lane) = pack8(y);
            } }
    }
}

__device__ __forceinline__ void phase_gatesum(LAS unsigned char* lds, int Ml) {
    const PView p(lds); const int tid = fresh_tid();
    const u32x4* YB = (const u32x4*)(p.ws + WS_YB); u32x4* SB = (u32x4*)(p.ws + WS_SB); const bf16* Z = (const bf16*)(p.ws + WS_Z);
    constexpr size_t NV = (size_t)M * 1024 / 8; const size_t nv = (size_t)Ml * 128;
    constexpr int R = 2;
    const size_t stride = (size_t)fresh_grid() * 512;
    for (size_t i0 = (size_t)fresh_blk() * 512 + tid; i0 < nv; i0 += R * stride) {
        u32x4 va[R][4], ga[R][4];
#pragma unroll
        for (int k = 0; k < R; ++k) { const size_t i = (i0 + k * stride < nv) ? i0 + k * stride : i0; const size_t row = i >> 7; const int col = (int)(i & 127) * 8;
            const bf16* gz = Z + row * PROJ + C_GATE + col;
#pragma unroll
            for (int n = 0; n < 4; ++n) { va[k][n] = YB[i + n * NV]; ga[k][n] = *(const u32x4*)(gz + 1024 * n); } }
#pragma unroll
        for (int k = 0; k < R; ++k) { const size_t i = i0 + k * stride; if (i >= nv) break;
            float o[8];
#pragma unroll
            for (int j = 0; j < 8; ++j) o[j] = 0.f;
#pragma unroll
            for (int n = 0; n < 4; ++n) { float y[8], g[8]; unpack8(va[k][n], y); unpack8(ga[k][n], g);
#pragma unroll
                for (int j = 0; j < 8; ++j) o[j] += y[j] / (1.0f + __expf(-g[j])); }
            SB[i] = pack8(o); }
    }
}

__device__ __forceinline__ void phase_ln1_router(int l, LAS unsigned char* lds, bool to_dummy, int Ml) {
    const PView p(lds);
    const int tid = fresh_tid(), lane = tid & 63, wave = __builtin_amdgcn_readfirstlane(tid >> 6), blk = fresh_blk(), G = fresh_grid();
    bf16* X = (bf16*)(p.ws + WS_X); bf16* H = (bf16*)(p.ws + WS_H); bf16* HLO = (bf16*)(p.ws + WS_HLO);
    const float* modl = (const float*)(p.ws + WS_MODV) + (size_t)l * 9 * 6144;
    const float* lng = p.in(I_LNG) + (l * 2 + 0) * 1024; const float* lnb = p.in(I_LNB) + (l * 2 + 0) * 1024;
    int* topi = (int*)(p.ws + WS_TOPI); float* topg = (float*)(p.ws + WS_TOPG); int* hist = (int*)(p.ws + WS_HIST);
    LAS int* lh = (LAS int*)lds;
    const int rpb_ = Ml / G;
    if (tid < 32) lh[tid] = 0;
    constexpr int R = 3;
    for (int i0 = wave; i0 < rpb_; i0 += 8 * R) {
        f32x4 xv[R][4];
#pragma unroll
        for (int k = 0; k < R; ++k) { const int i = min(i0 + 8 * k, rpb_ - 1); row_load16b(X + (size_t)(blk * rpb_ + i) * 1024, lane, xv[k]); }
#pragma unroll
        for (int k = 0; k < R; ++k) { const int i = i0 + 8 * k; if (i >= rpb_) break;
            const int row = blk * rpb_ + i;
            row_ln(xv[k], lng, lnb, lane);
            row_store16b((to_dummy ? (bf16*)(p.ws + WS_SB32) : X) + (size_t)row * 1024, lane, xv[k]);
            const float* mv = modl + (size_t)row_seg(row) * 6144;
            { f32x4 hv_[4]; row_mod_store(xv[k], mv + 3072, mv + 4096, H + (size_t)row * 1024, lane, hv_); }
        }
    }
    asm volatile("s_waitcnt vmcnt(0)" ::: "memory");
    __syncthreads();
    const int ntile = (rpb_ + 15) >> 4;
    const int r16 = lane & 15, q4 = lane >> 4;
    LAS f32x4* part = (LAS f32x4*)(lds + 1024);
    {
        const bf16* wh = (const bf16*)(p.ws + WS_WRT) + (size_t)(l * 2) * 32 * 1024 + (size_t)r16 * 1024 + 8 * q4 + 128 * wave; const bf16* wl = wh + 32 * 1024;
        bf16x8 w0h[4], w0l[4], w1h[4], w1l[4];
#pragma unroll
        for (int ks = 0; ks < 4; ++ks) { w0h[ks] = *(const bf16x8*)(wh + 32 * ks); w0l[ks] = *(const bf16x8*)(wl + 32 * ks); w1h[ks] = *(const bf16x8*)(wh + 16 * 1024 + 32 * ks); w1l[ks] = *(const bf16x8*)(wl + 16 * 1024 + 32 * ks); }
#pragma unroll
        for (int t = 0; t < 5; ++t) if (t < ntile) {
            const bf16* ah = H + (size_t)(blk * rpb_ + 16 * t + r16) * 1024 + 8 * q4 + 128 * wave;
            f32x4 a0 = (f32x4){0.f, 0.f, 0.f, 0.f}, a1 = a0;
#pragma unroll
            for (int ks = 0; ks < 4; ++ks) { const bf16x8 xh = *(const bf16x8*)(ah + 32 * ks);
                a0 = __builtin_amdgcn_mfma_f32_16x16x32_bf16(xh, w0l[ks], a0, 0, 0, 0); a0 = __builtin_amdgcn_mfma_f32_16x16x32_bf16(xh, w0h[ks], a0, 0, 0, 0);
                a1 = __builtin_amdgcn_mfma_f32_16x16x32_bf16(xh, w1l[ks], a1, 0, 0, 0); a1 = __builtin_amdgcn_mfma_f32_16x16x32_bf16(xh, w1h[ks], a1, 0, 0, 0); }
            part[((wave * 5 + t) * 2 + 0) * 64 + lane] = a0; part[((wave * 5 + t) * 2 + 1) * 64 + lane] = a1;
        }
    }
    __syncthreads();
    if (wave < ntile) {
        f32x4 acc0 = (f32x4){0.f, 0.f, 0.f, 0.f}, acc1 = acc0;
#pragma unroll
        for (int w = 0; w < 8; ++w) { acc0 += part[((w * 5 + wave) * 2 + 0) * 64 + lane]; acc1 += part[((w * 5 + wave) * 2 + 1) * 64 + lane]; }
        const float* br = p.in(I_BR) + l * 32; const float b0 = br[r16], b1 = br[16 + r16];
#pragma unroll
        for (int r = 0; r < 4; ++r) {
            float v0 = acc0[r] + b0, v1 = acc1[r] + b1;
            float tv[4]; int ti[4];
#pragma unroll
            for (int k = 0; k < 4; ++k) {
                float bv; int bi; if (v1 > v0) { bv = v1; bi = 16 + r16; } else { bv = v0; bi = r16; }
#pragma unroll
                for (int o = 1; o < 16; o <<= 1) { const float ov = shx(bv, o, lane); const int oi = shx(bi, o, lane); if (ov > bv || (ov == bv && oi < bi)) { bv = ov; bi = oi; } }
                tv[k] = bv; ti[k] = bi; if (bi == r16) v0 = -INFINITY; if (bi == 16 + r16) v1 = -INFINITY;
            }
            const int rl = 16 * wave + 4 * q4 + r;
            if (r16 == 0 && rl < rpb_) {
                const int row = blk * rpb_ + rl;
                const float e1 = __expf(tv[1] - tv[0]), e2 = __expf(tv[2] - tv[0]), e3 = __expf(tv[3] - tv[0]); const float inv = 1.0f / (1.0f + e1 + e2 + e3);
                *(int4*)(topi + (size_t)row * 4) = make_int4(ti[0], ti[1], ti[2], ti[3]);
                *(float4*)(topg + (size_t)row * 4) = make_float4(inv, e1 * inv, e2 * inv, e3 * inv);
                atomicAdd((int*)&lh[ti[0]], 1); atomicAdd((int*)&lh[ti[1]], 1); atomicAdd((int*)&lh[ti[2]], 1); atomicAdd((int*)&lh[ti[3]], 1);
            }
        }
    }
    __syncthreads();
    if (tid < 32) hist[blk * 32 + tid] = lh[tid];
}

__device__ __forceinline__ void phase_moe_slots(LAS unsigned char* lds, int Ml) {
    const PView p(lds);
    const int tid = fresh_tid(), lane = tid & 63, wave = tid >> 6, blk = fresh_blk(), G = fresh_grid();
    const int* hist = (const int*)(p.ws + WS_HIST); const int* topi = (const int*)(p.ws + WS_TOPI); int* slot = (int*)(p.ws + WS_SLOT); int* tile_e = (int*)(p.ws + WS_TILEE);
    const bf16* H = (const bf16*)(p.ws + WS_H); bf16* HP = (bf16*)(p.ws + WS_HP);
    LAS int* tot = (LAS int*)lds;   LAS int* base = tot + 32; LAS int* startp = tot + 64; LAS int* sl = tot + 128;
    const int rpb_ = Ml / G;
    if (tid < 32) { int t = 0, mb = 0;
#pragma unroll 4
        for (int b2 = 0; b2 < G; ++b2) { const int c = hist[b2 * 32 + tid]; t += c; mb += (b2 < blk) ? c : 0; } tot[tid] = t; base[tid] = mb; }
    __syncthreads();
    if (tid == 0) { int s = 0;
#pragma unroll 1
        for (int e = 0; e < 32; ++e) { startp[e] = s; const int pad = ((tot[e] + 255) >> 8) << 8;
            if (blk == 0) {
#pragma unroll 1
                for (int t = s >> 8; t < ((s + pad) >> 8); ++t) tile_e[t] = e; }
            s += pad; }
        if (blk == 0) tile_e[320] = s >> 8; }
    __syncthreads();
    LAS int* ent = tot + 512;
    for (int i = tid; i < rpb_ * 4; i += 512) ent[i] = topi[(size_t)blk * rpb_ * 4 + i];
    __syncthreads();
    for (int i = tid; i < rpb_ * 4; i += 512) { const int e = ent[i]; int rank = 0;
        for (int j = 0; j < i; ++j) rank += (ent[j] == e) ? 1 : 0;
        const int sv = startp[e] + base[e] + rank; sl[i] = sv; slot[(size_t)blk * rpb_ * 4 + i] = sv; }
    __syncthreads();
    int* stok = (int*)(p.ws + WS_STOK);
    for (int i = tid; i < rpb_ * 4; i += 512) stok[sl[i]] = blk * rpb_ + (i >> 2);
    if (blk == 0) for (int e = 0; e < 32; ++e) { const int s0 = startp[e] + tot[e], s1 = startp[e] + (((tot[e] + 255) >> 8) << 8); for (int q = s0 + tid; q < s1; q += 512) stok[q] = 0; }
}

__device__ __forceinline__ void phase_ln2(LAS unsigned char* lds, int l, bool to_dummy, int Ml) {
    const PView p(lds); const int tid = fresh_tid();
    const int lane = tid & 63, gw = fresh_blk() * 8 + (tid >> 6), NGW = fresh_grid() * 8;
    bf16* X = (bf16*)(p.ws + WS_X); bf16* H = (bf16*)(p.ws + WS_H); const bf16* Y2 = (const bf16*)(p.ws + WS_Y2);
    const float* modv = (const float*)(p.ws + WS_MODV);
    const float* lng = p.in(I_LNG) + (l * 2 + 1) * 1024; const float* lnb = p.in(I_LNB) + (l * 2 + 1) * 1024;
    const int* slot = (const int*)(p.ws + WS_SLOT); const float* topg = (const float*)(p.ws + WS_TOPG);
    constexpr int R = 3;
    for (int row0 = gw; row0 < Ml; row0 += R * NGW) {
        int4 sl[R]; float4 gt[R];
#pragma unroll
        for (int k = 0; k < R; ++k) { const int row = min(row0 + k * NGW, Ml - 1); sl[k] = *(const int4*)(slot + (size_t)row * 4); gt[k] = *(const float4*)(topg + (size_t)row * 4); }
        u32x2 yw[R][4][4]; f32x4 xv[R][4];
#pragma unroll
        for (int k = 0; k < R; ++k) { const int row = min(row0 + k * NGW, Ml - 1); const int sls[4] = {sl[k].x, sl[k].y, sl[k].z, sl[k].w};
#pragma unroll
            for (int e = 0; e < 4; ++e) { const u32x2* yp = (const u32x2*)(Y2 + (size_t)sls[e] * 1024) + lane;
#pragma unroll
                for (int j = 0; j < 4; ++j) yw[k][e][j] = yp[64 * j]; }
            row_load16b(X + (size_t)row * 1024, lane, xv[k]); }
#pragma unroll
        for (int k = 0; k < R; ++k) { const int row = row0 + k * NGW; if (row >= Ml) break;
            const float gts[4] = {gt[k].x, gt[k].y, gt[k].z, gt[k].w};
            f32x4 y[4];
#pragma unroll
            for (int j = 0; j < 4; ++j) y[j] = (f32x4){0.f, 0.f, 0.f, 0.f};
#pragma unroll
            for (int e = 0; e < 4; ++e)
#pragma unroll
                for (int j = 0; j < 4; ++j) { const u32x2 w = yw[k][e][j]; y[j] += (f32x4){bf2f(w.x & 0xffffu), bf2f(w.x >> 16), bf2f(w.y & 0xffffu), bf2f(w.y >> 16)} * gts[e]; }
            const int s = row_seg(row); const float* g2 = modv + (size_t)(l * 9 + s) * 6144 + 5120;
            f32x4 v[4];
#pragma unroll
            for (int j = 0; j < 4; ++j) v[j] = xv[k][j] * DN_ALPHA + *((const f32x4*)g2 + lane + 64 * j) * y[j];
            row_ln(v, lng, lnb, lane);
            if (l < DEPTH - 1) {
                row_store16b((to_dummy ? (bf16*)(p.ws + WS_SB32) : X) + (size_t)row * 1024, lane, v);
                const float* mv = modv + (size_t)((l + 1) * 9 + s) * 6144; f32x4 hv[4];
                row_mod_store(v, mv, mv + 1024, H + (size_t)row * 1024, lane, hv);
            } else if (row < ML) row_store16(p.out + (size_t)row * 1024, lane, v);
        }
    }
}

constexpr int PH_PER_LAYER = 12, N_PHASES = 2 + DEPTH * PH_PER_LAYER;
__global__ void __launch_bounds__(512, 2) fwd_kernel(Params p) {
    extern __shared__ __attribute__((aligned(16))) unsigned char lds_raw[];
    LAS unsigned char* lds = (LAS unsigned char*)lds_raw;
    {
        const int tid = threadIdx.x;
        if (tid < 16) ((LAS unsigned*)(lds + MISC_OFF))[tid] = 0u;
        if (tid < 25) ((LAS unsigned long long*)(lds + PT_OFF))[tid] = (unsigned long long)p.in[tid];
        if (tid == 25) ((LAS unsigned long long*)(lds + PT_OFF))[25] = (unsigned long long)p.out;
        if (tid == 26) ((LAS unsigned long long*)(lds + PT_OFF))[26] = (unsigned long long)p.ws;
    }
    __syncthreads();
#if !MK_PER_PHASE
    { const PView pv(lds); const XcdBarrier b0 = xcd_barrier_post((unsigned*)(pv.ws + WS_CTL) + CW_BAR, (volatile LAS unsigned*)(lds + MISC_OFF + 32));
      if (threadIdx.x == 0) ((volatile LAS unsigned*)(lds + MISC_OFF))[12] = b0.x; }
    __syncthreads();
#define GRID_BAR() do { XcdBarrier b_; b_.bar = (unsigned*)((unsigned char*)(__attribute__((address_space(1))) unsigned char*)ld_ptr_bits(lds, PT_WS) + WS_CTL) + CW_BAR; b_.st = (volatile LAS unsigned*)(lds + MISC_OFF + 32); \
        b_.x = ((volatile LAS unsigned*)(lds + MISC_OFF))[12]; xcd_barrier(b_); } while (0)
#else
#define GRID_BAR() do {} while (0)
#endif
#if MK_PER_PHASE
    const int lo = p.ph_lo, hi = p.ph_hi;
#else
    constexpr int lo = 0, hi = N_PHASES;
#endif
#define IN(k) (lo <= (k) && (k) < hi)
#define SEAM(k) do { if (IN(k) && IN((k) + 1)) { GRID_BAR(); if (PROBE_DUP_MASK & (1 << 17)) GRID_BAR(); } } while (0)

    if (IN(0)) { for (int rep_ = 0; rep_ < ((PROBE_DUP_MASK >> 16) & 1) + 1; ++rep_) phase_prologue(lds); } SEAM(0);
    if (IN(1)) { phase_init_h(lds); } SEAM(1);
    for (int l = 0; l < DEPTH; ++l) {
        const int pb = 2 + l * PH_PER_LAYER;
        const int Ml = (l == DEPTH - 1) ? ML : M;
        if (IN(pb + 0)) { for (int rep_ = 0; rep_ < ((PROBE_DUP_MASK >> 0) & 1) + 1; ++rep_) {
            const PView pv(lds); unsigned char* ws = pv.ws; const int G = fresh_grid(), blk = fresh_blk();
            pg8::Gemm g{(const pg8::bf16_t*)(ws + WS_H), (const pg8::bf16_t*)(ws + WS_WIN) + (size_t)l * PROJ * 1024, M, PROJ, 1024};
            pg8::InProjOrder S; S.init(G, blk);
            pg8::EpiZ E{(pg8::bf16_t*)(ws + WS_Z), PROJ, (const float*)(ws + WS_ROPEA)};
            pg8::gemm_phase<pg8::EpiZ, pg8::InProjOrder, true, true>(lds, g, S, E);
        } } SEAM(pb + 0);
        if (IN(pb + 1)) { for (int rep_ = 0; rep_ < ((PROBE_DUP_MASK >> 1) & 1) + 1; ++rep_) { phase_prep(lds, l); } } SEAM(pb + 1);
        if (IN(pb + 2)) { phase_mixers<1 + ((PROBE_DUP_MASK >> 11) & 1), 1 + ((PROBE_DUP_MASK >> 12) & 1)>(l, lds, 0); } SEAM(pb + 2);
        if (IN(pb + 3)) { for (int rep_ = 0; rep_ < ((PROBE_DUP_MASK >> 3) & 1) + 1; ++rep_) { phase_postscan(lds, l); } } SEAM(pb + 3);
        if (IN(pb + 4)) { for (int rep_ = 0; rep_ < ((PROBE_DUP_MASK >> 4) & 1) + 1; ++rep_) {
            const PView pv(lds); unsigned char* ws = pv.ws; const int G = fresh_grid(), blk = fresh_blk();
            pg8::Gemm g{(const pg8::bf16_t*)(ws + WS_OB), (const pg8::bf16_t*)(ws + WS_WBR) + (size_t)l * 4 * 1024 * 512, 4 * M, 4096, 512};
            pg8::BranchOrder S{G, blk, (Ml / 256) * 16};
            pg8::EpiBranch E{(pg8::bf16_t*)(ws + WS_YB)};
            pg8::gemm_phase<pg8::EpiBranch, pg8::BranchOrder, true, true>(lds, g, S, E);
        } } SEAM(pb + 4);
        if (IN(pb + 5)) { for (int rep_ = 0; rep_ < ((PROBE_DUP_MASK >> 5) & 1) + 1; ++rep_) phase_gatesum(lds, Ml); } SEAM(pb + 5);
        if (IN(pb + 6)) { for (int rep_ = ((PROBE_DUP_MASK >> 6) & 1) ? 0 : 1; rep_ < 2; ++rep_) {
            const PView pv(lds); unsigned char* ws = pv.ws; const int G = fresh_grid(), blk = fresh_blk();
            pg8::Gemm g{(const pg8::bf16_t*)(ws + WS_SB), (const pg8::bf16_t*)(ws + WS_WOUT) + (size_t)l * 1024 * 1024, M, 1024, 1024};
            pg8::StaticOrder S; S.init(Ml, 1024, G, blk);
            pg8::EpiOut E{(pg8::bf16_t*)(ws + WS_X), (const float*)(ws + WS_MODV) + (size_t)l * 9 * 6144, (pg8::bf16_t*)(ws + (rep_ == 0 ? WS_SB32 : WS_X))};
            pg8::gemm_phase<pg8::EpiOut, pg8::StaticOrder, true, true>(lds, g, S, E);
        } } SEAM(pb + 6);
        if (IN(pb + 7)) {
#if PROBE_DUP_MASK & (1 << 18)
            phase_ln1_router(l, lds, true, Ml);
#endif
            phase_ln1_router(l, lds, false, Ml); } SEAM(pb + 7);
        if (IN(pb + 8)) { for (int rep_ = 0; rep_ < ((PROBE_DUP_MASK >> 7) & 1) + 1; ++rep_) { phase_moe_slots(lds, Ml); } } SEAM(pb + 8);
        if (IN(pb + 9)) { for (int rep_ = 0; rep_ < ((PROBE_DUP_MASK >> 8) & 1) + 1; ++rep_) {
            const PView pv(lds); unsigned char* ws = pv.ws; const int G = fresh_grid(), blk = fresh_blk();
            pg8::Gemm g{(const pg8::bf16_t*)(ws + WS_H), (const pg8::bf16_t*)(ws + WS_WGU) + (size_t)l * 32 * 2048 * 1024, NSLOT, 32 * 2048, 1024, (const int*)(ws + WS_STOK)};
            pg8::MoeOrder<8> S{G, blk, (const int*)(ws + WS_TILEE)};
            pg8::EpiGU E{(pg8::bf16_t*)(ws + WS_ACT), pv.in(I_BGU) + (size_t)l * 32 * 2048};
            pg8::gemm_phase<pg8::EpiGU, pg8::MoeOrder<8>, true, true, true>(lds, g, S, E);
        } } SEAM(pb + 9);
        if (IN(pb + 10)) { for (int rep_ = 0; rep_ < ((PROBE_DUP_MASK >> 9) & 1) + 1; ++rep_) {
            const PView pv(lds); unsigned char* ws = pv.ws; const int G = fresh_grid(), blk = fresh_blk();
            pg8::Gemm g{(const pg8::bf16_t*)(ws + WS_ACT), (const pg8::bf16_t*)(ws + WS_WDN) + (size_t)l * 32 * 1024 * 1024, NSLOT, 32 * 1024, 1024};
            pg8::MoeOrder<4> S{G, blk, (const int*)(ws + WS_TILEE)};
            pg8::EpiDown E{(pg8::bf16_t*)(ws + WS_Y2), pv.in(I_BDN) + (size_t)l * 32 * 1024};
            pg8::gemm_phase<pg8::EpiDown, pg8::MoeOrder<4>, true, true>(lds, g, S, E);
        } } SEAM(pb + 10);
        if (IN(pb + 11)) {
#if PROBE_DUP_MASK & (1 << 19)
            phase_ln2(lds, l, true, Ml);
#endif
            phase_ln2(lds, l, false, Ml); } SEAM(pb + 11);
    }
#undef IN
#undef SEAM
}

extern "C" void kernel_launch(void* const* d_in, const int* in_sizes, int n_in, void* d_out, int out_size, void* d_ws, size_t ws_size, hipStream_t stream) {
    static int grid = 0;
    if (grid == 0) {
        if (n_in != 25 || in_sizes[0] != ML * D || out_size != ML * D || ws_size < WS_END) { fprintf(stderr, "kernel_launch: unexpected problem (n_in %d, in0 %d, out %d, ws %zu < %zu)\n", n_in, n_in > 0 ? in_sizes[0] : -1, out_size, ws_size, (size_t)WS_END); grid = -1; return; }
        int dev = 0, cus = 0, per_cu = 0;
        if (hipGetDevice(&dev) != hipSuccess || hipDeviceGetAttribute(&cus, hipDeviceAttributeMultiprocessorCount, dev) != hipSuccess) { grid = -1; return; }
        if (hipFuncSetAttribute((const void*)fwd_kernel, hipFuncAttributeMaxDynamicSharedMemorySize, LDS_BYTES) != hipSuccess) { fprintf(stderr, "kernel_launch: hipFuncSetAttribute failed\n"); grid = -1; return; }
        if (hipOccupancyMaxActiveBlocksPerMultiprocessor(&per_cu, (const void*)fwd_kernel, 512, LDS_BYTES) != hipSuccess || per_cu < 1) fprintf(stderr, "kernel_launch: occupancy query says %d\n", per_cu);
        (void)hipGetLastError();
        grid = cus;
        if (grid != 256) { fprintf(stderr, "kernel_launch: built for 256 CUs, device has %d\n", cus); grid = (cus >= 256) ? 256 : -1; }
    }
    if (grid < 0) return;
    if (hipMemsetAsync((char*)d_ws + WS_CTL, 0, CTL_ZERO_BYTES, stream) != hipSuccess) return;
    Params a{};
    for (int i = 0; i < 25; ++i) a.in[i] = (const float*)d_in[i];
    a.out = (float*)d_out; a.ws = (unsigned char*)d_ws;
#if MK_PER_PHASE
    for (int ph = 0; ph < N_PHASES; ++ph) { a.ph_lo = ph; a.ph_hi = ph + 1; hipLaunchKernelGGL(fwd_kernel, dim3(grid), dim3(512), LDS_BYTES, stream, a); }
#else
    a.ph_lo = 0; a.ph_hi = N_PHASES;
    hipLaunchKernelGGL(fwd_kernel, dim3(grid), dim3(512), LDS_BYTES, stream, a);
#endif
    const hipError_t le = hipPeekAtLastError();
    if (le != hipSuccess) fprintf(stderr, "kernel_launch: launch failed: %s\n", hipGetErrorName(le));
}
```

```cpp
#include <hip/hip_runtime.h>
#include <cstdio>
#include <cstdint>

#ifndef MK_PER_PHASE
#define MK_PER_PHASE 0
#endif
#ifndef PROBE_DUP_MASK
#define PROBE_DUP_MASK 0
#endif
#define XB_TMO      128
#define XB_XCNT(j)  (256  + 64 * (j))
#define XB_XSUB(j)  (1280 + 64 * (j))
#define XB_XGEN(j)  (2304 + 64 * (j))
#define XB_TOP      3328
#define XB_TOPGEN   3392
#define XCD_BAR_WORDS 3456
#define XB_SPIN_CAP (1u << 18)
#define LAS __attribute__((address_space(3)))

__device__ __forceinline__ unsigned xb_ld(unsigned* p)              { return __hip_atomic_load(p, __ATOMIC_RELAXED, __HIP_MEMORY_SCOPE_AGENT); }
__device__ __forceinline__ unsigned xb_add(unsigned* p, unsigned v) { return __hip_atomic_fetch_add(p, v, __ATOMIC_RELAXED, __HIP_MEMORY_SCOPE_AGENT); }
__device__ __forceinline__ unsigned xb_xcc_id() { return (unsigned)__builtin_amdgcn_s_getreg((3 << 11) | 20) & 0xFu; }
#define XB_SPIN(cond, bar) do { unsigned _sp = 0; while (cond) { __builtin_amdgcn_s_sleep(1); \
    if ((++_sp & 255u) == 0u) { if (xb_ld(&(bar)[XB_TMO])) break; if (_sp > XB_SPIN_CAP) { atomicAdd(&(bar)[XB_TMO], 1u); break; } } } } while (0)

struct XcdBarrier {
    unsigned* bar; unsigned x;
    volatile LAS unsigned* st;
};

__device__ __forceinline__ XcdBarrier xcd_barrier_post(unsigned* bar, volatile LAS unsigned* st) {
    XcdBarrier b; b.bar = bar; b.x = xb_xcc_id(); b.st = st;
    if (threadIdx.x == 0) (void)xb_add(&bar[XB_XCNT(b.x)], 1u);
    return b;
}
__device__ __forceinline__ void xcd_barrier_complete(unsigned* bar, unsigned x, unsigned& nloc, unsigned& nx) {
    const unsigned G = gridDim.x * gridDim.y * gridDim.z;
    unsigned sum, cnt, mine, sp = 0u;
    for (;;) {
        sum = 0u; cnt = 0u; mine = 0u;
#pragma unroll
        for (unsigned j = 0; j < 16; ++j) { const unsigned c = xb_ld(&bar[XB_XCNT(j)]); sum += c; cnt += (c > 0u) ? 1u : 0u; mine = (j == x) ? c : mine; }
        if (sum == G) break;
        __builtin_amdgcn_s_sleep(1);
        if ((++sp & 255u) == 0u) { if (xb_ld(&bar[XB_TMO])) break; if (sp > XB_SPIN_CAP) { atomicAdd(&bar[XB_TMO], 1u); break; } }
    }
    nloc = mine > 0u ? mine : 1u; nx = cnt > 0u ? cnt : 1u;
}

__device__ __forceinline__ void xcd_barrier(const XcdBarrier& b) {
    asm volatile("s_waitcnt vmcnt(0)" ::: "memory");
    __syncthreads();
    if (threadIdx.x == 0) {
        unsigned* bar = b.bar;
        __builtin_amdgcn_s_waitcnt(0);
        unsigned nloc = b.st[0], nx = b.st[1];
        if (nloc == 0u) { xcd_barrier_complete(bar, b.x, nloc, nx); b.st[0] = nloc; b.st[1] = nx; }
        const unsigned old = xb_add(&bar[XB_XSUB(b.x)], 1u);
        const unsigned gen = old / nloc;
        if (old + 1u == (gen + 1u) * nloc) {
            __builtin_amdgcn_fence(__ATOMIC_RELEASE, "agent");
            asm volatile("s_waitcnt vmcnt(0)" ::: "memory");
            const unsigned og = xb_add(&bar[XB_TOP], 1u);
            const unsigned tg = og / nx;
            if (og + 1u == (tg + 1u) * nx) xb_add(&bar[XB_TOPGEN], 1u);
            else XB_SPIN(xb_ld(&bar[XB_TOPGEN]) == tg, bar);
            __builtin_amdgcn_fence(__ATOMIC_ACQUIRE, "agent");
            xb_add(&bar[XB_XGEN(b.x)], 1u);
            asm volatile("s_waitcnt vmcnt(0)" ::: "memory");
        } else {
            XB_SPIN(xb_ld(&bar[XB_XGEN(b.x)]) == gen, bar);
            __builtin_amdgcn_fence(__ATOMIC_ACQUIRE, "agent");
            asm volatile("s_waitcnt vmcnt(0)" ::: "memory");
        }
    }
    __syncthreads();
}
namespace pg8 {
#define PG8_LAS __attribute__((address_space(3)))
typedef unsigned short bf16_t;
typedef short bf16x8 __attribute__((ext_vector_type(8)));
typedef float f32x4 __attribute__((ext_vector_type(4)));
typedef unsigned u32x4 __attribute__((ext_vector_type(4)));
constexpr int BM = 256, BK = 64, HALF = 128, HTB = HALF * BK * 2  , STAGE_BYTES = 8 * HTB, NXCD = 8, WGM = 8;

__host__ __device__ __forceinline__ int lds_byte(int r, int c) { const int st = (r >> 4) * 2 + (c >> 5), rr = r & 15, cc = c & 31, ob = rr * 64 + cc * 2; return st * 1024 + (ob ^ (((ob >> 9) & 1) << 5)); }
__host__ __device__ __forceinline__ void stage_rc(int b, int& R, int& C) { const int st = b / 1024, sb = b % 1024, swz = sb ^ (((sb >> 9) & 1) << 5); R = (st >> 1) * 16 + swz / 64; C = (st & 1) * 32 + (swz % 64) / 2; }
__host__ __device__ __forceinline__ int perm32(int rho) { const int n = rho >> 4, i = rho & 15; return 8 * (i >> 2) + 4 * n + (i & 3); }

struct Unit { int pm, pn; };
struct Gemm { const bf16_t* A; const bf16_t* Bt; int M, N, K; const int* stok; };

struct StaticOrder {
    int nM, nN, nwg, G, c;
    __host__ __device__ void init(int M, int N, int G_, int c_) { nM = M / BM; nN = N / BM; nwg = nM * nN; G = G_; c = c_; }
    __host__ __device__ bool next(int i, Unit& u) const {
        const long L = (long)i * G + c; if (L >= nwg) return false;
        int wgid = (int)L; { const int q = nwg / NXCD, r = nwg % NXCD, xcd = wgid % NXCD, off = wgid / NXCD; wgid = (xcd < r ? xcd * (q + 1) : r * (q + 1) + (xcd - r) * q) + off; }
        const int nig = WGM * nN, gid = wgid / nig, fm = gid * WGM, gsz = (nM - fm) < WGM ? (nM - fm) : WGM;
        u.pm = fm + ((wgid % nig) % gsz); u.pn = (wgid % nig) / gsz; return true;
    }
    __device__ __forceinline__ void a_ready(const Unit&) const {}
    __device__ __forceinline__ void done(const Unit&) const {}
};

__device__ __forceinline__ unsigned cvt_pk_bf16(float lo, float hi) { unsigned r; asm volatile("v_cvt_pk_bf16_f32 %0, %1, %2" : "=v"(r) : "v"(lo), "v"(hi)); return r; }
template <class Epi, class Sched, bool ALIGN_EPI = false, bool SP2 = false, bool GATHER = false>
__device__ __forceinline__ void gemm_phase(PG8_LAS unsigned char* lds, const Gemm g, const Sched& S, const Epi& E) {
    int tid_ = threadIdx.x; asm volatile("" : "+v"(tid_));
    const int tid = tid_, wid = __builtin_amdgcn_readfirstlane(tid >> 6), lane = tid & 63, wr = wid >> 2, wc = wid & 3, fr = lane & 15, fq = lane >> 4;
    const int K = g.K, nt = K / BK;
    unsigned voffA[2], voffB[2];
#pragma unroll
    for (int i = 0; i < 2; ++i) { int R, C; stage_rc(tid * 16 + i * 8192, R, C); const int Rb = Epi::PERM ? ((R & ~31) + perm32(R & 31)) : R;
        voffA[i] = (unsigned)(R * K + C) * 2u; voffB[i] = (unsigned)(Rb * K + C) * 2u; }
    static_assert(!GATHER || SP2, "GATHER is wired into the SP2 loop only");
    int gR[2], gC[2]; unsigned vA0[2], vA1[2], vN0[2], vN1[2];
    if constexpr (GATHER) {
#pragma unroll
        for (int i = 0; i < 2; ++i) { stage_rc(tid * 16 + i * 8192, gR[i], gC[i]); vA0[i] = vA1[i] = vN0[i] = vN1[i] = 0u; }
    }
#define PG8_GOFFS(pm_, d0, d1) do { _Pragma("unroll") for (int _i = 0; _i < 2; ++_i) { \
        (d0)[_i] = (unsigned)(g.stok[(pm_) * BM + gR[_i]] * K + gC[_i]) * 2u; (d1)[_i] = (unsigned)(g.stok[(pm_) * BM + HALF + gR[_i]] * K + gC[_i]) * 2u; } } while (0)
#define PG8_STAGE_A(bufoff, ngbase, gbase, gvoff) do { if constexpr (GATHER) { PG8_STAGE(bufoff, gbase, gvoff); } else { PG8_STAGE(bufoff, ngbase, voffA); } } while (0)
    const size_t kstep = (size_t)(BK * 2);
    const size_t hstep = (size_t)HALF * K * 2;
    const size_t tstep = 2 * hstep;
    const unsigned ldsw = (unsigned)wid * 1024u;
    const int aoff = lds_byte(wr * 64 + fr, fq * 8), boff = lds_byte(wc * 32 + fr, fq * 8);
#define PG8_SA(b, h) (((b) * 2 + (h)) * HTB)
#define PG8_SB(b, h) ((4 + (b) * 2 + (h)) * HTB)
#define PG8_STAGE(bufoff, gbase, voff) do { _Pragma("unroll") for (int _i = 0; _i < 2; ++_i) \
        __builtin_amdgcn_global_load_lds((const unsigned*)((const char*)(gbase) + (voff)[_i]), (PG8_LAS unsigned*)(lds + (bufoff) + ldsw + _i * 8192), 16, 0, 0); } while (0)
#define PG8_LDA(dst, b, h) do { _Pragma("unroll") for (int m = 0; m < 4; ++m) _Pragma("unroll") for (int k = 0; k < 2; ++k) dst[m][k] = *(const PG8_LAS bf16x8*)(lds + PG8_SA(b, h) + aoff + m * 2048 + k * 1024); } while (0)
#define PG8_LDB(dst, b, h) do { _Pragma("unroll") for (int n = 0; n < 2; ++n) _Pragma("unroll") for (int k = 0; k < 2; ++k) dst[n][k] = *(const PG8_LAS bf16x8*)(lds + PG8_SB(b, h) + boff + n * 2048 + k * 1024); } while (0)
#define PG8_MMA(ai, bj, At, Bt) do { __builtin_amdgcn_s_setprio(1); _Pragma("unroll") for (int m = 0; m < 4; ++m) _Pragma("unroll") for (int n = 0; n < 2; ++n) _Pragma("unroll") for (int k = 0; k < 2; ++k) \
        acc[ai][bj][m][n] = __builtin_amdgcn_mfma_f32_16x16x32_bf16(Bt[n][k], At[m][k], acc[ai][bj][m][n], 0, 0, 0); __builtin_amdgcn_s_setprio(0); } while (0)
#define PG8_WAIT_V(n) asm volatile("s_waitcnt vmcnt(" #n ")" ::: "memory")
#define PG8_WAIT_L(n) asm volatile("s_waitcnt lgkmcnt(" #n ")" ::: "memory")
#define PG8_BAR __builtin_amdgcn_s_barrier()
#define PG8_SCHED __builtin_amdgcn_sched_barrier(0)
    Unit cur, nxt; int ui = 0;
    if (!S.next(0, cur)) return;
    f32x4 acc[2][2][4][2];
#pragma unroll
    for (int a = 0; a < 2; ++a)
#pragma unroll
        for (int b = 0; b < 2; ++b)
#pragma unroll
            for (int m = 0; m < 4; ++m)
#pragma unroll
                for (int n = 0; n < 2; ++n) acc[a][b][m][n] = (f32x4){0.f, 0.f, 0.f, 0.f};
    bf16x8 At[4][2], B0[2][2], B1[2][2];
    const char* cA = (const char*)g.A + (size_t)cur.pm * tstep; const char* cB = (const char*)g.Bt + (size_t)cur.pn * tstep;
    const char* const gA = (const char*)g.A;
    if constexpr (GATHER) { PG8_GOFFS(cur.pm, vA0, vA1); }
    S.a_ready(cur);
    if constexpr (SP2) {
        PG8_STAGE(PG8_SB(0, 0), cB, voffB); PG8_STAGE(PG8_SB(0, 1), cB + hstep, voffB); PG8_STAGE_A(PG8_SA(0, 0), cA, gA, vA0); PG8_STAGE_A(PG8_SA(0, 1), cA + hstep, gA, vA1);
        if (wr == 1) PG8_BAR;
        PG8_WAIT_V(2); PG8_BAR;
        PG8_STAGE(PG8_SB(1, 0), cB + kstep, voffB); PG8_STAGE_A(PG8_SA(1, 0), cA + kstep, gA + kstep, vA0); PG8_STAGE(PG8_SB(1, 1), cB + hstep + kstep, voffB);
        PG8_WAIT_V(6); PG8_BAR;
    } else {
        PG8_STAGE(PG8_SB(0, 0), cB, voffB); PG8_STAGE(PG8_SA(0, 0), cA, voffA); PG8_STAGE(PG8_SB(0, 1), cB + hstep, voffB); PG8_STAGE(PG8_SA(0, 1), cA + hstep, voffA);
        if (wr == 1) PG8_BAR;
        PG8_WAIT_V(4); PG8_BAR;
        PG8_STAGE(PG8_SB(1, 0), cB + kstep, voffB); PG8_STAGE(PG8_SA(1, 0), cA + kstep, voffA); PG8_STAGE(PG8_SB(1, 1), cB + hstep + kstep, voffB);
        PG8_WAIT_V(6); PG8_BAR;
    }
    for (;;) {
        const bool has_next = S.next(ui + 1, nxt);
        if constexpr (GATHER) { if (has_next) { PG8_GOFFS(nxt.pm, vN0, vN1); } else { vN0[0] = vA0[0]; vN0[1] = vA0[1]; vN1[0] = vA1[0]; vN1[1] = vA1[1]; } }
        const char* nA = has_next ? (const char*)g.A + (size_t)nxt.pm * tstep : cA; const char* nB = has_next ? (const char*)g.Bt + (size_t)nxt.pn * tstep : cB;
        for (int t = 0; t < nt; t += 2) {
            const bool last = (t == nt - 2);
            const char* a1 = cA + (size_t)(t + 1) * kstep;
            const char* a2 = last ? nA : cA + (size_t)(t + 2) * kstep; const char* b2 = last ? nB : cB + (size_t)(t + 2) * kstep;
            const char* a3 = a2 + kstep; const char* b3 = b2 + kstep;
            if (last && has_next) S.a_ready(nxt);
            if constexpr (SP2) {
            unsigned s0[2], s1[2]; const char* g2 = gA;
            if constexpr (GATHER) { s0[0] = last ? vN0[0] : vA0[0]; s0[1] = last ? vN0[1] : vA0[1]; s1[0] = last ? vN1[0] : vA1[0]; s1[1] = last ? vN1[1] : vA1[1]; g2 = gA + (last ? (size_t)0 : (size_t)(t + 2) * kstep); }
            PG8_LDB(B0, 0, 0); PG8_LDB(B1, 0, 1); PG8_SCHED; PG8_LDA(At, 0, 0); PG8_STAGE_A(PG8_SA(1, 1), a1 + hstep, gA + (size_t)(t + 1) * kstep, vA1);
            PG8_WAIT_V(8); PG8_WAIT_L(0); PG8_BAR; PG8_MMA(0, 0, At, B0); PG8_MMA(0, 1, At, B1); PG8_BAR; PG8_SCHED;
            PG8_LDA(At, 0, 1); PG8_STAGE(PG8_SB(0, 0), b2, voffB); PG8_STAGE(PG8_SB(0, 1), b2 + hstep, voffB); PG8_STAGE_A(PG8_SA(0, 0), a2, g2, s0);
            PG8_WAIT_V(8); PG8_WAIT_L(0); PG8_BAR; PG8_MMA(1, 0, At, B0); PG8_MMA(1, 1, At, B1); PG8_BAR; PG8_SCHED;
            PG8_LDB(B0, 1, 0); PG8_LDB(B1, 1, 1); PG8_SCHED; PG8_LDA(At, 1, 0); PG8_STAGE_A(PG8_SA(0, 1), a2 + hstep, g2, s1);
            PG8_WAIT_V(8); PG8_WAIT_L(0); PG8_BAR; PG8_MMA(0, 0, At, B0); PG8_MMA(0, 1, At, B1); PG8_BAR; PG8_SCHED;
            PG8_LDA(At, 1, 1); PG8_STAGE(PG8_SB(1, 0), b3, voffB); PG8_STAGE(PG8_SB(1, 1), b3 + hstep, voffB); PG8_STAGE_A(PG8_SA(1, 0), a3, g2 + kstep, s0);
            PG8_WAIT_V(8); PG8_WAIT_L(0); PG8_BAR; PG8_MMA(1, 0, At, B0); PG8_MMA(1, 1, At, B1); PG8_BAR; PG8_SCHED;
            } else {
            PG8_LDB(B0, 0, 0); PG8_SCHED; PG8_LDA(At, 0, 0); PG8_STAGE(PG8_SA(1, 1), a1 + hstep, voffA);
            PG8_WAIT_L(8); PG8_BAR; PG8_WAIT_L(0); PG8_MMA(0, 0, At, B0); PG8_BAR; PG8_SCHED;
            PG8_LDB(B1, 0, 1); PG8_STAGE(PG8_SB(0, 0), b2, voffB);
            PG8_BAR; PG8_WAIT_L(0); PG8_MMA(0, 1, At, B1); PG8_BAR;
            PG8_LDA(At, 0, 1); PG8_STAGE(PG8_SA(0, 0), a2, voffA);
            PG8_BAR; PG8_WAIT_L(0); PG8_MMA(1, 0, At, B0); PG8_BAR; PG8_SCHED;
            PG8_STAGE(PG8_SB(0, 1), b2 + hstep, voffB);
            PG8_WAIT_V(6); PG8_BAR; PG8_MMA(1, 1, At, B1); PG8_BAR;
            PG8_LDB(B0, 1, 0); PG8_SCHED; PG8_LDA(At, 1, 0); PG8_STAGE(PG8_SA(0, 1), a2 + hstep, voffA);
            PG8_WAIT_L(8); PG8_BAR; PG8_WAIT_L(0); PG8_MMA(0, 0, At, B0); PG8_BAR; PG8_SCHED;
            PG8_LDB(B1, 1, 1); PG8_STAGE(PG8_SB(1, 0), b3, voffB);
            PG8_BAR; PG8_WAIT_L(0); PG8_MMA(0, 1, At, B1); PG8_BAR;
            PG8_LDA(At, 1, 1); PG8_STAGE(PG8_SA(1, 0), a3, voffA);
            PG8_BAR; PG8_WAIT_L(0); PG8_MMA(1, 0, At, B0); PG8_BAR; PG8_SCHED;
            PG8_STAGE(PG8_SB(1, 1), b3 + hstep, voffB);
            PG8_WAIT_V(6); PG8_BAR; PG8_MMA(1, 1, At, B1); PG8_BAR;
            }
        }
        if constexpr (ALIGN_EPI) { if (wr == 0) PG8_BAR; }
        if constexpr (!Epi::AFTER_DRAIN) { E(acc, cur, wr, wc, fr, fq); S.done(cur); }
        if (!has_next) break;
#pragma unroll
        for (int a = 0; a < 2; ++a)
#pragma unroll
            for (int b = 0; b < 2; ++b)
#pragma unroll
                for (int m = 0; m < 4; ++m)
#pragma unroll
                    for (int n = 0; n < 2; ++n) acc[a][b][m][n] = (f32x4){0.f, 0.f, 0.f, 0.f};
        cur = nxt; cA = nA; cB = nB; ++ui;
        if constexpr (GATHER) { vA0[0] = vN0[0]; vA0[1] = vN0[1]; vA1[0] = vN1[0]; vA1[1] = vN1[1]; }
        if constexpr (ALIGN_EPI) { if (wr == 1) PG8_BAR; }
    }
    PG8_WAIT_V(0);
    if constexpr (!ALIGN_EPI) { if (wr == 0) PG8_BAR; }
    PG8_BAR;
    if constexpr (Epi::AFTER_DRAIN) { E.fused(acc, cur, wr, wc, fr, fq, lds, wid, lane); S.done(cur); }
#undef PG8_GOFFS
#undef PG8_STAGE_A
#undef PG8_SA
#undef PG8_SB
#undef PG8_STAGE
#undef PG8_LDA
#undef PG8_LDB
#undef PG8_MMA
#undef PG8_WAIT_V
#undef PG8_WAIT_L
#undef PG8_BAR
#undef PG8_SCHED
}
}

typedef unsigned short bf16;
typedef short bf16x8 __attribute__((ext_vector_type(8)));
typedef float f32x4 __attribute__((ext_vector_type(4)));
typedef unsigned u32x4 __attribute__((ext_vector_type(4)));
typedef unsigned u32x2 __attribute__((ext_vector_type(2)));

constexpr int D = 1024, NB = 8, SEQ = 2048, DEPTH = 4, CTXL = 256;
constexpr int ML = NB * SEQ, MC = NB * CTXL, M = ML + MC, MT = M / 256;
constexpr int PROJ = 11008;
constexpr int C_RQ = 0, C_RK = 512, C_RV = 1024, C_RG = 1536, C_HQ = 2048, C_HF = 2560, C_HI = 3584, C_HG = 4096;
constexpr int C_NQ = 4608, C_NK = 5120, C_NV = 5632, C_GQ = 6144, C_GK = 6656, C_GV = 6784, C_GATE = 6912;
constexpr int NEXP = 32, NSLOT = 320 * 256, MAXTILES = 320;
constexpr float DN_ALPHA = 1.681792830507429f;
constexpr float LN_EPS = 1e-5f, NORM_EPS = 1e-6f;

enum { I_X = 0, I_C, I_CTX, I_CCTX, I_WMOD, I_BMOD, I_WIN, I_RDEC, I_RGNG, I_RGNB, I_HLB, I_HNG, I_RPB, I_QNG, I_KNG, I_WBR, I_WOUT, I_LNG, I_LNB, I_WR, I_BR, I_WGU, I_BGU, I_WDN, I_BDN };

constexpr size_t MiB = 1u << 20;
constexpr size_t WS_CTL = 0, CTL_ZERO_BYTES = 1 * MiB;
constexpr size_t WS_MODV = 1 * MiB;
constexpr size_t WS_LOWER = WS_MODV + 896 * 1024;
constexpr size_t WS_ROPEA = WS_MODV + 912 * 1024;
constexpr size_t WS_ROPEB = WS_MODV + 928 * 1024;
constexpr size_t WS_HIST = WS_MODV + 944 * 1024;
constexpr size_t WS_TILEE = WS_MODV + 976 * 1024;
constexpr size_t WS_GQB = WS_MODV + 1000 * 1024;
constexpr size_t WS_TOPI = 2 * MiB, WS_TOPG = 2 * MiB + 320 * 1024, WS_SLOT = 2 * MiB + 640 * 1024;
constexpr size_t WS_STOK = 3 * MiB + 512 * 1024;
constexpr size_t WS_WRT = 3 * MiB;
constexpr size_t WS_WIN = 4 * MiB;
constexpr size_t WS_WBR = 90 * MiB;
constexpr size_t WS_WOUT = 106 * MiB;
constexpr size_t WS_WGU = 114 * MiB;
constexpr size_t WS_WDN = 626 * MiB;
constexpr size_t WS_X = 882 * MiB;
constexpr size_t WS_H = 954 * MiB;
constexpr size_t WS_Z = 990 * MiB;
constexpr size_t WS_RQ = 1377 * MiB, WS_RK = 1395 * MiB, WS_HQ = 1413 * MiB, WS_GQ = 1431 * MiB, WS_GK = 1449 * MiB;
constexpr size_t WS_OS = 1454 * MiB;
constexpr size_t WS_OB = 1598 * MiB;
constexpr size_t WS_SB32 = 1670 * MiB;
constexpr size_t WS_SB = 1742 * MiB;
constexpr size_t WS_HP = 1778 * MiB;
constexpr size_t WS_ACT = 1938 * MiB;
constexpr size_t WS_Y2 = 2098 * MiB;
constexpr size_t WS_YB = 2258 * MiB;
constexpr size_t WS_HLO = 2402 * MiB;
constexpr size_t WS_END = 2438 * MiB;
static_assert(WS_WIN + (size_t)4 * PROJ * 1024 * 2 <= WS_WBR && WS_Z + (size_t)M * PROJ * 2 <= WS_RQ && WS_OS + (size_t)4 * M * 512 * 4 <= WS_OB, "ws map");

constexpr int CW_BAR = 4096;
constexpr int CW_QUEUE = 16384;
constexpr int CW_CONVQ = 20480;
constexpr int CW_DONE = 21504;

constexpr int LDS_BYTES = 147456;
constexpr int MISC_OFF = LDS_BYTES - 512;

__device__ __forceinline__ float bf2f(unsigned v) { return __uint_as_float(v << 16); }
typedef __bf16 hwbf2 __attribute__((ext_vector_type(2)));
typedef float f32x2_ __attribute__((ext_vector_type(2)));
__device__ __forceinline__ unsigned pk2(float lo, float hi) { const f32x2_ v = {lo, hi}; return __builtin_bit_cast(unsigned, __builtin_convertvector(v, hwbf2)); }
__device__ __forceinline__ unsigned f2bf(float f) { return pk2(f, 0.f) & 0xffffu; }
__device__ __forceinline__ float sigmoidf_(float x) { return 1.0f / (1.0f + __expf(-x)); }
__device__ __forceinline__ float siluf_(float x) { return x / (1.0f + __expf(-x)); }
__device__ __forceinline__ void unpack8(u32x4 r, float (&v)[8]) {
    v[0] = bf2f(r.x & 0xffffu); v[1] = bf2f(r.x >> 16); v[2] = bf2f(r.y & 0xffffu); v[3] = bf2f(r.y >> 16);
    v[4] = bf2f(r.z & 0xffffu); v[5] = bf2f(r.z >> 16); v[6] = bf2f(r.w & 0xffffu); v[7] = bf2f(r.w >> 16);
}
__device__ __forceinline__ u32x4 pack8(const float (&v)[8]) { u32x4 r; r.x = pk2(v[0], v[1]); r.y = pk2(v[2], v[3]); r.z = pk2(v[4], v[5]); r.w = pk2(v[6], v[7]); return r; }
__device__ __forceinline__ int shx(int v, int m, int lane) { return __builtin_amdgcn_ds_bpermute((lane ^ m) << 2, v); }
__device__ __forceinline__ unsigned shx(unsigned v, int m, int lane) { return (unsigned)__builtin_amdgcn_ds_bpermute((lane ^ m) << 2, (int)v); }
__device__ __forceinline__ float shx(float v, int m, int lane) { return __int_as_float(__builtin_amdgcn_ds_bpermute((lane ^ m) << 2, __float_as_int(v))); }
__device__ __forceinline__ float wave_sum(float v, int lane) {
#pragma unroll
    for (int o = 1; o < 64; o <<= 1) v += shx(v, o, lane);
    return v;
}
#define LDS_FENCE() asm volatile("s_waitcnt lgkmcnt(0)" ::: "memory")

template <int NK>
__device__ __forceinline__ f32x4 mma16(const LAS bf16* A, int lda, const LAS bf16* Bt, int ldb, f32x4 acc, int lane) {
    const int r = lane & 15, q = lane >> 4;
    const LAS bf16* pa = A + r * lda + 8 * q; const LAS bf16* pb = Bt + r * ldb + 8 * q;
#pragma unroll
    for (int k = 0; k < NK; ++k) {
        const bf16x8 a = *(const LAS bf16x8*)(pa + 32 * k); const bf16x8 b = *(const LAS bf16x8*)(pb + 32 * k);
        acc = __builtin_amdgcn_mfma_f32_16x16x32_bf16(a, b, acc, 0, 0, 0);
    }
    return acc;
}

struct Params { const float* in[25]; float* out; unsigned char* ws; int ph_lo, ph_hi; };
constexpr int PT_OFF = MISC_OFF + 64, PT_OUT = 25, PT_WS = 26;
__device__ __forceinline__ unsigned long long ld_ptr_bits(const LAS unsigned char* lds, int i) {
    unsigned a_ = (unsigned)(size_t)(lds + PT_OFF) + 8u * (unsigned)i; asm volatile("" : "+s"(a_));
    const LAS unsigned* t = (const LAS unsigned*)(size_t)a_;
    const unsigned lo = (unsigned)__builtin_amdgcn_readfirstlane((int)t[0]), hi = (unsigned)__builtin_amdgcn_readfirstlane((int)t[1]);
    return ((unsigned long long)hi << 32) | lo;
}
struct PView {
    const LAS unsigned char* lds; unsigned char* ws; float* out;
    __device__ __forceinline__ PView(const LAS unsigned char* l) : lds(l) { ws = (unsigned char*)(__attribute__((address_space(1))) unsigned char*)ld_ptr_bits(l, PT_WS); out = (float*)(__attribute__((address_space(1))) float*)ld_ptr_bits(l, PT_OUT); }
    __device__ __forceinline__ const float* in(int i) const { return (const float*)(const __attribute__((address_space(1))) float*)ld_ptr_bits(lds, i); }
};
__device__ __forceinline__ int fresh_tid() { int t = threadIdx.x; asm volatile("" : "+v"(t)); return t; }
__device__ __forceinline__ int fresh_blk() { int t = blockIdx.x; asm volatile("" : "+s"(t)); return t; }
__device__ __forceinline__ int fresh_grid() { int t = gridDim.x; asm volatile("" : "+s"(t)); return t; }

namespace pg8 {
struct EpiZ {
    static constexpr bool PERM = true, AFTER_DRAIN = false;
    bf16_t* O; int ldc; const float* ropeA;
    __device__ __forceinline__ void operator()(const f32x4 (&acc)[2][2][4][2], const Unit& u, int wr, int wc, int fr, int fq) const {
        const int row0 = u.pm * BM + wr * 64 + fr, col0 = u.pn * BM + wc * 32 + 8 * fq;
        const bool ret = u.pn < 4, rot = ret && (u.pm < 64);
        const float ksc = (u.pn >= 2 && ret) ? 0.08838834764831845f : 1.0f;
#pragma unroll
        for (int ai = 0; ai < 2; ++ai)
#pragma unroll
            for (int m = 0; m < 4; ++m) { const int row = row0 + ai * HALF + m * 16; bf16_t* rowp = O + (size_t)row * ldc + col0;
                const int t = row & 2047, prow = t >> 6, pcol = t & 63;
#pragma unroll
                for (int bj = 0; bj < 2; ++bj) { f32x4 v0 = acc[ai][bj][m][0], v1 = acc[ai][bj][m][1];
                    if (rot) { const int g8 = ((col0 + bj * HALF) & 127) >> 3; const int pos = (g8 >> 3) ? pcol : prow;
                        const float* tb = ropeA + (pos * 32 + 4 * (g8 & 7)) * 2; const f32x4 t0 = *(const f32x4*)tb, t1 = *(const f32x4*)(tb + 4);
                        const f32x4 cs = (f32x4){t0[0], t0[2], t1[0], t1[2]}, sn = (f32x4){t0[1], t0[3], t1[1], t1[3]};
                        const f32x4 x1 = v0, x2 = v1; v0 = x1 * cs - x2 * sn; v1 = x1 * sn + x2 * cs; }
                    if (ret) { v0 = v0 * ksc; v1 = v1 * ksc; }
                    u32x4 w; w.x = cvt_pk_bf16(v0[0], v0[1]); w.y = cvt_pk_bf16(v0[2], v0[3]); w.z = cvt_pk_bf16(v1[0], v1[1]); w.w = cvt_pk_bf16(v1[2], v1[3]);
                    *(u32x4*)(rowp + bj * HALF) = w; } }
    }
};
struct EpiBranch {
    static constexpr bool PERM = true, AFTER_DRAIN = false;
    bf16_t* YB;
    __device__ __forceinline__ void operator()(const f32x4 (&acc)[2][2][4][2], const Unit& u, int wr, int wc, int fr, int fq) const {
        const int n = u.pn >> 2, pnl = u.pn & 3, pml = u.pm - 72 * n;
        const int row0 = pml * BM + wr * 64 + fr, col0 = pnl * BM + wc * 32 + 8 * fq;
        bf16_t* yb = YB + (size_t)n * 18432 * 1024;
#pragma unroll
        for (int ai = 0; ai < 2; ++ai)
#pragma unroll
            for (int m = 0; m < 4; ++m) { bf16_t* rowp = yb + (size_t)(row0 + ai * HALF + m * 16) * 1024 + col0;
#pragma unroll
                for (int bj = 0; bj < 2; ++bj) { const f32x4 v0 = acc[ai][bj][m][0], v1 = acc[ai][bj][m][1];
                    u32x4 w; w.x = cvt_pk_bf16(v0[0], v0[1]); w.y = cvt_pk_bf16(v0[2], v0[3]); w.z = cvt_pk_bf16(v1[0], v1[1]); w.w = cvt_pk_bf16(v1[2], v1[3]);
                    *(u32x4*)(rowp + bj * HALF) = w; } }
    }
};
struct EpiOut {
    static constexpr bool PERM = true, AFTER_DRAIN = false;
    bf16_t* X; const float* modl; bf16_t* Xo;
    __device__ __forceinline__ void operator()(const f32x4 (&acc)[2][2][4][2], const Unit& u, int wr, int wc, int fr, int fq) const {
        const int row0 = u.pm * BM + wr * 64 + fr, col0 = u.pn * BM + wc * 32 + 8 * fq;
        const int s = (u.pm < 64) ? (u.pm >> 3) : 8;
        const float* g1 = modl + s * 6144 + 2048;
#pragma unroll
        for (int bj = 0; bj < 2; ++bj) { const f32x4 g0 = *(const f32x4*)(g1 + col0 + bj * HALF), g4 = *(const f32x4*)(g1 + col0 + bj * HALF + 4);
#pragma unroll
            for (int ai = 0; ai < 2; ++ai)
#pragma unroll
                for (int m = 0; m < 4; ++m) { const size_t o_ = (size_t)(row0 + ai * HALF + m * 16) * 1024 + col0 + bj * HALF;
                    const u32x4 xr = *(const u32x4*)(X + o_);
                    const f32x4 x0 = (f32x4){__uint_as_float(xr.x << 16), __uint_as_float(xr.x & 0xffff0000u), __uint_as_float(xr.y << 16), __uint_as_float(xr.y & 0xffff0000u)};
                    const f32x4 x1 = (f32x4){__uint_as_float(xr.z << 16), __uint_as_float(xr.z & 0xffff0000u), __uint_as_float(xr.w << 16), __uint_as_float(xr.w & 0xffff0000u)};
                    const f32x4 v0 = x0 * DN_ALPHA + g0 * acc[ai][bj][m][0], v1 = x1 * DN_ALPHA + g4 * acc[ai][bj][m][1];
                    u32x4 w; w.x = cvt_pk_bf16(v0[0], v0[1]); w.y = cvt_pk_bf16(v0[2], v0[3]); w.z = cvt_pk_bf16(v1[0], v1[1]); w.w = cvt_pk_bf16(v1[2], v1[3]);
                    *(u32x4*)(Xo + o_) = w; }
            asm volatile("" ::: "memory"); }
    }
};
struct EpiGU {
    static constexpr bool PERM = true, AFTER_DRAIN = false;
    bf16_t* ACT; const float* bgu;
    __device__ __forceinline__ void operator()(const f32x4 (&acc)[2][2][4][2], const Unit& u, int wr, int wc, int fr, int fq) const {
        const int e = u.pn >> 3, pnl = u.pn & 7;
        const int row0 = u.pm * BM + wr * 64 + fr, cin = wc * 32 + 8 * fq;
        const float* bg = bgu + e * 2048 + 128 * pnl + cin; const float* bu = bg + 1024;
        const f32x4 bg0 = *(const f32x4*)bg, bg1 = *(const f32x4*)(bg + 4), bu0 = *(const f32x4*)bu, bu1 = *(const f32x4*)(bu + 4);
#pragma unroll
        for (int ai = 0; ai < 2; ++ai)
#pragma unroll
            for (int m = 0; m < 4; ++m) { const int row = row0 + ai * HALF + m * 16;
                f32x4 g0 = acc[ai][0][m][0] + bg0, g1 = acc[ai][0][m][1] + bg1, u0 = acc[ai][1][m][0] + bu0, u1 = acc[ai][1][m][1] + bu1;
                f32x4 a0, a1;
#pragma unroll
                for (int j = 0; j < 4; ++j) {
                    float gg = fminf(g0[j], 7.0f), uu = fminf(fmaxf(u0[j], -7.0f), 7.0f); a0[j] = gg / (1.0f + __expf(-1.702f * gg)) * (uu + 1.0f);
                    gg = fminf(g1[j], 7.0f); uu = fminf(fmaxf(u1[j], -7.0f), 7.0f); a1[j] = gg / (1.0f + __expf(-1.702f * gg)) * (uu + 1.0f); }
                u32x4 w; w.x = cvt_pk_bf16(a0[0], a0[1]); w.y = cvt_pk_bf16(a0[2], a0[3]); w.z = cvt_pk_bf16(a1[0], a1[1]); w.w = cvt_pk_bf16(a1[2], a1[3]);
                *(u32x4*)(ACT + (size_t)row * 1024 + 128 * pnl + cin) = w; }
    }
};
struct EpiDown {
    static constexpr bool PERM = true, AFTER_DRAIN = false;
    bf16_t* Y2; const float* bdn;
    __device__ __forceinline__ void operator()(const f32x4 (&acc)[2][2][4][2], const Unit& u, int wr, int wc, int fr, int fq) const {
        const int e = u.pn >> 2, pnl = u.pn & 3;
        const int row0 = u.pm * BM + wr * 64 + fr, col0 = pnl * BM + wc * 32 + 8 * fq;
        f32x4 bv[2][2];
#pragma unroll
        for (int bj = 0; bj < 2; ++bj)
#pragma unroll
            for (int n = 0; n < 2; ++n) bv[bj][n] = *(const f32x4*)(bdn + e * 1024 + col0 + bj * HALF + 4 * n);
#pragma unroll
        for (int ai = 0; ai < 2; ++ai)
#pragma unroll
            for (int m = 0; m < 4; ++m) { bf16_t* rowp = Y2 + (size_t)(row0 + ai * HALF + m * 16) * 1024 + col0;
#pragma unroll
                for (int bj = 0; bj < 2; ++bj) { const f32x4 v0 = acc[ai][bj][m][0] + bv[bj][0], v1 = acc[ai][bj][m][1] + bv[bj][1];
                    u32x4 w; w.x = cvt_pk_bf16(v0[0], v0[1]); w.y = cvt_pk_bf16(v0[2], v0[3]); w.z = cvt_pk_bf16(v1[0], v1[1]); w.w = cvt_pk_bf16(v1[2], v1[3]);
                    *(u32x4*)(rowp + bj * HALF) = w; } }
    }
};
constexpr int INPROJ_DEFER = 24;
struct InProjOrder {
    StaticOrder so; int G, c;
    __device__ void init(int G_, int c_) { so.init(M, 42 * BM, G_, c_); G = G_; c = c_; }
    __device__ bool next(int i, Unit& u) const {
        if (so.next(i, u)) return true;
        const int L = i * G + c - 72 * 42;
        if (L >= 0 && L < 72 - INPROJ_DEFER) { u.pm = INPROJ_DEFER + L; u.pn = 42; return true; }
        return false;
    }
    __device__ __forceinline__ void a_ready(const Unit&) const {}
    __device__ __forceinline__ void done(const Unit&) const {}
};
struct SingleUnit {
    int pm, pn;
    __device__ bool next(int i, Unit& u) const { if (i) return false; u.pm = pm; u.pn = pn; return true; }
    __device__ __forceinline__ void a_ready(const Unit&) const {}
    __device__ __forceinline__ void done(const Unit&) const {}
};
struct BranchOrder {
    int G, c, nunits;
    __device__ bool next(int i, Unit& u) const {
        const int np = nunits >> 4, x = c & 7, rank = c >> 3, nb = G >> 3;
        const int p0 = (x * np) >> 3, p1 = ((x + 1) * np) >> 3, v = i * nb + rank;
        if (v >= (p1 - p0) * 16) return false;
        const int pml = p0 + (v >> 4), n = (v >> 2) & 3, pnl = v & 3;
        u.pm = n * 72 + pml; u.pn = n * 4 + pnl; return true;
    }
    __device__ __forceinline__ void a_ready(const Unit&) const {}
    __device__ __forceinline__ void done(const Unit&) const {}
};
template <int NP> struct MoeOrder {
    int G, c; const int* tile_e;
    __device__ bool next(int i, Unit& u) const {
        const int nt = __builtin_amdgcn_readfirstlane(tile_e[320]);
        const int x = c & 7, rank = c >> 3, nb = G >> 3;
        const int t0 = (x * nt) >> 3, t1 = ((x + 1) * nt) >> 3, v = i * nb + rank;
        if (v >= (t1 - t0) * NP) return false;
        const int t = t0 + v / NP; u.pm = t; u.pn = __builtin_amdgcn_readfirstlane(tile_e[t]) * NP + (v % NP); return true;
    }
    __device__ __forceinline__ void a_ready(const Unit&) const {}
    __device__ __forceinline__ void done(const Unit&) const {}
};
}

__device__ __forceinline__ int ret_perm_row(int n) {
    const int head = n >> 7, dd = n & 127, half = dd >> 6, r = dd & 63, part = r >> 5, i = r & 31;
    return (head << 7) + (((half << 3) + (i >> 2)) << 3) + (part << 2) + (i & 3);
}
__device__ __forceinline__ void p0_transpose_item(const float* W, int K, int N, bf16* WT, int k0, int n0, int dst_row0, LAS float* scr, int lane, bool perm = false) {
    const float* src = W + (size_t)k0 * N + n0 + lane;
    float v[64];
#pragma unroll
    for (int i = 0; i < 64; ++i) v[i] = __builtin_nontemporal_load(src + (size_t)i * N);
#pragma unroll
    for (int i = 0; i < 64; ++i) scr[i * 65 + lane] = v[i];
    LDS_FENCE();
    const int c = lane & 7, nn = lane >> 3;
#pragma unroll
    for (int j = 0; j < 8; ++j) { const int n = nn + 8 * j; const LAS float* s = scr + (8 * c) * 65 + n;
        u32x4 o; o.x = pk2(s[0 * 65], s[1 * 65]); o.y = pk2(s[2 * 65], s[3 * 65]); o.z = pk2(s[4 * 65], s[5 * 65]); o.w = pk2(s[6 * 65], s[7 * 65]);
        __builtin_nontemporal_store(o, (u32x4*)(WT + (size_t)(perm ? ret_perm_row(n0 + n) : dst_row0 + n) * K + k0 + 8 * c)); }
    LDS_FENCE();
}

constexpr int CONV_PER_L = 2752 + 512 + 256 + 16384 + 8192;
constexpr int CONV_IN_END = 2752, CONV_BR_END = 3264, CONV_OUT_END = 3520, CONV_GU_END = 19904, CONV_TOTAL = (DEPTH - 1) * CONV_PER_L;
__device__ __forceinline__ void convert_item(const PView& p, int l, int r, LAS float* scr, int lane) {
    unsigned char* ws = p.ws;
    const float* W; bf16* WT; int K, N, k0, n0, dr; bool perm = false;
    if (r < CONV_IN_END) { const int kb = r / 172, nb = r % 172;
        W = p.in(I_WIN) + (size_t)l * 1024 * PROJ; K = 1024; N = PROJ; WT = (bf16*)(ws + WS_WIN) + (size_t)l * PROJ * 1024; k0 = 64 * kb; n0 = 64 * nb; dr = n0; perm = nb < 16; }
    else if (r < CONV_BR_END) { const int r1 = r - CONV_IN_END, n = r1 >> 7, r2 = r1 & 127, kb = r2 >> 4, nb = r2 & 15;
        W = p.in(I_WBR) + (size_t)(l * 4 + n) * 512 * 1024; K = 512; N = 1024; WT = (bf16*)(ws + WS_WBR) + (size_t)(l * 4 + n) * 1024 * 512; k0 = 64 * kb; n0 = 64 * nb; dr = n0; }
    else if (r < CONV_OUT_END) { const int r1 = r - CONV_BR_END, kb = r1 >> 4, nb = r1 & 15;
        W = p.in(I_WOUT) + (size_t)l * 1024 * 1024; K = 1024; N = 1024; WT = (bf16*)(ws + WS_WOUT) + (size_t)l * 1024 * 1024; k0 = 64 * kb; n0 = 64 * nb; dr = n0; }
    else if (r < CONV_GU_END) { const int r1 = r - CONV_OUT_END, e = r1 >> 9, r2 = r1 & 511, kb = r2 >> 5, nb = r2 & 31;
        W = p.in(I_WGU) + (size_t)(l * 32 + e) * 1024 * 2048; K = 1024; N = 2048; WT = (bf16*)(ws + WS_WGU) + (size_t)(l * 32 + e) * 2048 * 1024; k0 = 64 * kb; n0 = 64 * nb;
        dr = (n0 < 1024) ? ((n0 >> 7) * 256 + (n0 & 127)) : ((((n0 - 1024) >> 7) * 256) + 128 + ((n0 - 1024) & 127)); }
    else { const int r1 = r - CONV_GU_END, e = r1 >> 8, r2 = r1 & 255, kb = r2 >> 4, nb = r2 & 15;
        W = p.in(I_WDN) + (size_t)(l * 32 + e) * 1024 * 1024; K = 1024; N = 1024; WT = (bf16*)(ws + WS_WDN) + (size_t)(l * 32 + e) * 1024 * 1024; k0 = 64 * kb; n0 = 64 * nb; dr = n0; }
    p0_transpose_item(W, K, N, WT, k0, n0, dr, scr, lane, perm);
}
__device__ __forceinline__ void convert_fill(LAS unsigned char* lds, int wmark, unsigned* done, int G) {
    const PView p(lds); const int tid = fresh_tid(), lane = tid & 63, wave = __builtin_amdgcn_readfirstlane(tid >> 6);
    unsigned* head = (unsigned*)(p.ws + WS_CTL) + CW_CONVQ;
    LAS float* scr = (LAS float*)(lds + wave * 16640);
    volatile LAS int* box = (volatile LAS int*)(lds + MISC_OFF + 20);
    __syncthreads();
    if (tid == 0) { __hip_atomic_fetch_add(done, 1u, __ATOMIC_RELAXED, __HIP_MEMORY_SCOPE_AGENT); __hip_atomic_fetch_max(head, (unsigned)wmark, __ATOMIC_RELAXED, __HIP_MEMORY_SCOPE_AGENT); }
#pragma unroll 1
    for (;;) {
        if (tid == 0) {
            int b = -1;
            if ((int)__hip_atomic_load(done, __ATOMIC_RELAXED, __HIP_MEMORY_SCOPE_AGENT) < G) { b = (int)__hip_atomic_fetch_add(head, 8u, __ATOMIC_RELAXED, __HIP_MEMORY_SCOPE_AGENT); if (b >= CONV_TOTAL) b = -1; }
            *box = b;
        }
        __syncthreads();
        const int b = __builtin_amdgcn_readfirstlane(*box);
        __syncthreads();
        if (b < 0) break;
        const int it = b + wave;
        if (it < CONV_TOTAL) { const int lq = it / CONV_PER_L; convert_item(p, 1 + lq, it - lq * CONV_PER_L, scr, lane); }
    }
}
__device__ __forceinline__ void convert_drain(LAS unsigned char* lds, int lo, int W) {
    const PView p(lds); const int tid = fresh_tid(), lane = tid & 63, wave = __builtin_amdgcn_readfirstlane(tid >> 6);
    unsigned* head = (unsigned*)(p.ws + WS_CTL) + CW_CONVQ;
    LAS float* scr = (LAS float*)(lds + wave * 16640);
    const int f = __builtin_amdgcn_readfirstlane((int)__hip_atomic_load(head, __ATOMIC_RELAXED, __HIP_MEMORY_SCOPE_AGENT));
    __syncthreads();
    const int gw = fresh_blk() * 8 + wave, NGW = fresh_grid() * 8;
#pragma unroll 1
    for (int it = max(lo, f) + gw; it < W; it += NGW) { const int lq = it / CONV_PER_L; convert_item(p, 1 + lq, it - lq * CONV_PER_L, scr, lane); }
}
__device__ __forceinline__ unsigned* conv_done_ptr(LAS unsigned char* lds, int l, int which) { const PView p(lds); return (unsigned*)(p.ws + WS_CTL) + CW_DONE + (l * 8 + which) * 16; }

__device__ __forceinline__ void phase_prologue(LAS unsigned char* lds) {
    const PView p(lds);
    const int tid = fresh_tid(), lane = tid & 63, wave = tid >> 6, G = fresh_grid(), blk = fresh_blk();
    unsigned char* ws = p.ws;
    __syncthreads();
    {
        LAS float* sc = (LAS float*)lds;
        LAS float* part = (LAS float*)(lds + 36864);
        float* modv = (float*)(ws + WS_MODV);
        bool have = false;
        for (int it = blk; it < 384; it += G) {
            if (!have) {
                for (int idx = tid; idx < 9 * 1024; idx += 512) { const int s = idx >> 10, k = idx & 1023; const float v = (s < 8) ? p.in(I_C)[s * 1024 + k] : p.in(I_CCTX)[k]; sc[idx] = v / (1.0f + __expf(-v)); }
                have = true; __syncthreads();
            }
            const int l = it / 96, nb = it % 96, n = nb * 64 + lane;
            float a[9];
#pragma unroll
            for (int s = 0; s < 9; ++s) a[s] = 0.f;
            const float* wm = p.in(I_WMOD) + ((size_t)l * 1024 + wave * 128) * 6144 + n;
#pragma unroll 4
            for (int kk = 0; kk < 128; ++kk) { const float wv = wm[(size_t)kk * 6144];
#pragma unroll
                for (int s = 0; s < 9; ++s) a[s] += sc[s * 1024 + wave * 128 + kk] * wv; }
#pragma unroll
            for (int s = 0; s < 9; ++s) part[(wave * 9 + s) * 64 + lane] = a[s];
            __syncthreads();
            for (int idx = tid; idx < 576; idx += 512) { const int s = idx >> 6, ln = idx & 63; float v = p.in(I_BMOD)[l * 6144 + nb * 64 + ln];
#pragma unroll
                for (int w = 0; w < 8; ++w) v += part[(w * 9 + s) * 64 + ln];
                modv[(size_t)(l * 9 + s) * 6144 + nb * 64 + ln] = v; }
            __syncthreads();
        }
        __syncthreads();
    }
    {
        const int gt = blk * 512 + tid;
        if (gt < 1024) {
            const int d = gt >> 9, c = gt & 511; const float* hb = p.in(I_HLB) + d * 2048 + c;
            const float v0 = hb[0], v1 = hb[512], v2 = hb[1024], v3 = hb[1536]; const float mx = fmaxf(fmaxf(v0, v1), fmaxf(v2, v3));
            const float e0 = expf(v0 - mx), e1 = expf(v1 - mx), e2 = expf(v2 - mx), e3 = expf(v3 - mx), inv = 1.0f / (e0 + e1 + e2 + e3);
            float* lo = (float*)(ws + WS_LOWER) + d * 2048 + c;
            lo[0] = 0.f; lo[512] = e1 * inv; lo[1024] = (e1 + e2) * inv; lo[1536] = (e1 + e2 + e3) * inv;
        } else if (gt < 1024 + 2048) {
            const int idx = gt - 1024, pos = idx >> 5, i = idx & 31; const float inv = powf(10000.0f, -(float)(2 * i) / 64.0f), ang = (float)pos * inv;
            float* t = (float*)(ws + WS_ROPEA) + idx * 2; t[0] = cosf(ang); t[1] = sinf(ang);
        } else if (gt < 1024 + 2048 + 1024) {
            const int idx = gt - 3072, pos = idx >> 4, i = idx & 15; const float inv = powf(10000.0f, -(float)(2 * i) / 32.0f), ang = (float)pos * inv;
            float* t = (float*)(ws + WS_ROPEB) + idx * 2; t[0] = cosf(ang); t[1] = sinf(ang);
        } else if (gt < 1024 + 2048 + 1024 + 4) {
            const int ll = gt - 4096; float mq = 0.f, mk = 0.f;
            for (int j = 0; j < 64; ++j) { mq = fmaxf(mq, fabsf(p.in(I_QNG)[ll * 64 + j])); mk = fmaxf(mk, fabsf(p.in(I_KNG)[ll * 64 + j])); }
            ((float*)(ws + WS_GQB))[ll] = 1.02f * 8.0f * mq * mk * 1.4426950408889634f;
        }
    }
    {
        bf16* wrt = (bf16*)(ws + WS_WRT); const float* wr = p.in(I_WR);
        for (int idx = blk * 512 + tid; idx < 4 * 32 * 1024; idx += G * 512) { const int l = idx >> 15, e = (idx >> 10) & 31, k = idx & 1023;
            const float w = wr[((size_t)l * 1024 + k) * 32 + e]; const unsigned hi = f2bf(w); const float lo = w - bf2f(hi);
            wrt[((size_t)(l * 2 + 0) * 32 + e) * 1024 + k] = (bf16)hi; wrt[((size_t)(l * 2 + 1) * 32 + e) * 1024 + k] = (bf16)f2bf(lo); }
    }
    {
        u32x2* X4 = (u32x2*)(ws + WS_X); const f32x4* x4 = (const f32x4*)p.in(I_X); const f32x4* c4 = (const f32x4*)p.in(I_CTX);
        for (size_t i = (size_t)blk * 512 + tid; i < (size_t)M * 256; i += (size_t)G * 512) { const f32x4 v = (i < (size_t)ML * 256) ? x4[i] : c4[i - (size_t)ML * 256];
            u32x2 w; w.x = pk2(v.x, v.y); w.y = pk2(v.z, v.w); X4[i] = w; }
    }
    {
        LAS float* scr = (LAS float*)(lds + wave * 16640);
        const int gw = blk * 8 + wave, NGW = G * 8;
#pragma unroll 1
        for (int it = gw; it < CONV_PER_L; it += NGW) convert_item(p, 0, it, scr, lane);
    }
}

__device__ __forceinline__ void row_load16(const float* rowp, int lane, f32x4 (&v)[4]) {
    const f32x4* r = (const f32x4*)rowp + lane;
#pragma unroll
    for (int j = 0; j < 4; ++j) v[j] = r[64 * j];
}
__device__ __forceinline__ void row_store16(float* rowp, int lane, const f32x4 (&v)[4]) {
    f32x4* r = (f32x4*)rowp + lane;
#pragma unroll
    for (int j = 0; j < 4; ++j) r[64 * j] = v[j];
}
__device__ __forceinline__ void row_load16b(const bf16* rowp, int lane, f32x4 (&v)[4]) {
    const u32x2* r = (const u32x2*)rowp + lane;
#pragma unroll
    for (int j = 0; j < 4; ++j) { const u32x2 w = r[64 * j]; v[j] = (f32x4){bf2f(w.x & 0xffffu), bf2f(w.x >> 16), bf2f(w.y & 0xffffu), bf2f(w.y >> 16)}; }
}
__device__ __forceinline__ void row_store16b(bf16* rowp, int lane, const f32x4 (&v)[4]) {
    u32x2* r = (u32x2*)rowp + lane;
#pragma unroll
    for (int j = 0; j < 4; ++j) { u32x2 w; w.x = pk2(v[j].x, v[j].y); w.y = pk2(v[j].z, v[j].w); r[64 * j] = w; }
}
__device__ __forceinline__ void row_ln(f32x4 (&v)[4], const float* g, const float* b, int lane) {
    float s = 0.f;
#pragma unroll
    for (int j = 0; j < 4; ++j) s += (v[j].x + v[j].y) + (v[j].z + v[j].w);
    const float mean = wave_sum(s, lane) * (1.f / 1024.f); float s2 = 0.f;
#pragma unroll
    for (int j = 0; j < 4; ++j) { v[j] = v[j] - mean; s2 += (v[j].x * v[j].x + v[j].y * v[j].y) + (v[j].z * v[j].z + v[j].w * v[j].w); }
    const float rstd = 1.f / sqrtf(wave_sum(s2, lane) * (1.f / 1024.f) + LN_EPS);
#pragma unroll
    for (int j = 0; j < 4; ++j) { const f32x4 gg = *((const f32x4*)g + lane + 64 * j), bb = *((const f32x4*)b + lane + 64 * j); v[j] = v[j] * rstd * gg + bb; }
}
__device__ __forceinline__ void row_mod_store(const f32x4 (&v)[4], const float* sh, const float* sc, bf16* hrow, int lane, f32x4 (&hv)[4]) {
#pragma unroll
    for (int j = 0; j < 4; ++j) { const f32x4 a = *((const f32x4*)sc + lane + 64 * j), c = *((const f32x4*)sh + lane + 64 * j);
        hv[j] = v[j] * (a + 1.0f) + c;
        u32x2 w; w.x = pk2(hv[j].x, hv[j].y); w.y = pk2(hv[j].z, hv[j].w);
        *((u32x2*)hrow + lane + 64 * j) = w; }
}
__device__ __forceinline__ void row_mod_store2(const f32x4 (&v)[4], const float* sh, const float* sc, bf16* hrow, bf16* lrow, int lane) {
#pragma unroll
    for (int j = 0; j < 4; ++j) { const f32x4 a = *((const f32x4*)sc + lane + 64 * j), c = *((const f32x4*)sh + lane + 64 * j);
        const f32x4 h = v[j] * (a + 1.0f) + c;
        const unsigned h0 = f2bf(h.x), h1 = f2bf(h.y), h2 = f2bf(h.z), h3 = f2bf(h.w);
        u32x2 w; w.x = h0 | (h1 << 16); w.y = h2 | (h3 << 16);
        *((u32x2*)hrow + lane + 64 * j) = w;
        u32x2 wl; wl.x = pk2(h.x - bf2f(h0), h.y - bf2f(h1)); wl.y = pk2(h.z - bf2f(h2), h.w - bf2f(h3));
        *((u32x2*)lrow + lane + 64 * j) = wl; }
}
__device__ __forceinline__ int row_seg(int row) { return row < ML ? (row >> 11) : 8; }

__device__ __forceinline__ void phase_init_h(LAS unsigned char* lds) {
    const PView p(lds); const int tid = fresh_tid();
    const int lane = tid & 63, gw = fresh_blk() * 8 + (tid >> 6), NGW = fresh_grid() * 8;
    const bf16* X = (const bf16*)(p.ws + WS_X); bf16* H = (bf16*)(p.ws + WS_H); const float* modv = (const float*)(p.ws + WS_MODV);
    for (int row = gw; row < M; row += NGW) {
        f32x4 v[4], hv[4]; row_load16b(X + (size_t)row * 1024, lane, v);
        const float* mv = modv + (size_t)row_seg(row) * 6144;
        row_mod_store(v, mv, mv + 1024, H + (size_t)row * 1024, lane, hv);
    }
}

__device__ __forceinline__ void phase_prep(LAS unsigned char* lds, int l) {
    const PView p(lds); const int tid = fresh_tid();
    const int lane = tid & 63, gw = fresh_blk() * 8 + (tid >> 6), NGW = fresh_grid() * 8;
    const bf16* Z = (const bf16*)(p.ws + WS_Z);
    bf16* RQ = (bf16*)(p.ws + WS_RQ); bf16* RK = (bf16*)(p.ws + WS_RK); bf16* HQ = (bf16*)(p.ws + WS_HQ); bf16* GQ = (bf16*)(p.ws + WS_GQ); bf16* GK = (bf16*)(p.ws + WS_GK);
    const float* ropeA = (const float*)(p.ws + WS_ROPEA); const float* ropeB = (const float*)(p.ws + WS_ROPEB);
    const float* qng = p.in(I_QNG) + l * 64; const float* kng = p.in(I_KNG) + l * 64;
    constexpr int R = 3;
    for (int row0 = gw; row0 < M; row0 += R * NGW) {
      u32x4 rawv[R][5];
#pragma unroll
      for (int k = 0; k < R; ++k) { const bf16* Zr = Z + (size_t)min(row0 + k * NGW, M - 1) * PROJ;
          rawv[k][0] = *(const u32x4*)(Zr + C_RQ + 8 * lane); rawv[k][1] = *(const u32x4*)(Zr + C_RK + 8 * lane); rawv[k][2] = *(const u32x4*)(Zr + C_HQ + 8 * lane);
          rawv[k][3] = *(const u32x4*)(Zr + C_GQ + 8 * lane); rawv[k][4] = *(const u32x4*)(Zr + C_GK + 8 * (lane & 15)); }
#pragma unroll
      for (int k = 0; k < R; ++k) { const int row = row0 + k * NGW; if (row >= M) break;
        const bool lat = row < ML; const int t = row & 2047, prow = t >> 6, pcol = t & 63;
#pragma unroll
        for (int which = 1; which < 2; ++which) {
            const u32x4 raw = rawv[k][3 + which];
            float x[8]; unpack8(raw, x);
            float ss = 0.f;
#pragma unroll
            for (int j = 0; j < 8; ++j) ss += x[j] * x[j];
            ss += shx(ss, 1, lane); ss += shx(ss, 2, lane); ss += shx(ss, 4, lane);
            const float rinv = 1.0f / sqrtf(ss * (1.0f / 64.0f) + NORM_EPS);
            const int g = lane & 7; const float* gn = (which ? kng : qng) + 8 * g;
#pragma unroll
            for (int j = 0; j < 8; ++j) x[j] = x[j] * rinv * gn[j];
            float px[8];
#pragma unroll
            for (int j = 0; j < 8; ++j) px[j] = shx(x[j], 2, lane);
            const bool isx1 = ((g >> 1) & 1) == 0; const int pos = (g < 4) ? prow : pcol;
            float o[8];
            if (lat) {
                const float* tb = ropeB + (pos * 16 + 8 * (g & 1)) * 2;
#pragma unroll
                for (int j = 0; j < 8; ++j) { const float cs = tb[2 * j], sn = tb[2 * j + 1]; o[j] = isx1 ? (x[j] * cs - px[j] * sn) : (px[j] * sn + x[j] * cs); }
            } else {
#pragma unroll
                for (int j = 0; j < 8; ++j) o[j] = x[j];
            }
            if (which == 1 && lane < 16) *(u32x4*)(GK + (size_t)row * 128 + 8 * lane) = pack8(o);
        }
    }
      }
}

constexpr int SC_QT = 0, SC_QH = 17408, SC_KT = 34816, SC_KHT = 78336, SC_VT = 96768, SC_P = 115200, SC_SUB = 124416, SC_DL = 126464, SC_END = 126976;
static_assert(SC_END <= MISC_OFF, "scan LDS");

__device__ __forceinline__ int scan_row0(int b, int dir, int n) {
    if (n < 4) return ML + b * 256 + (dir ? 255 - 64 * n : 64 * n);
    return b * 2048 + (dir ? 2047 - 64 * (n - 4) : 64 * (n - 4));
}
__device__ __forceinline__ int scan_row(int b, int dir, int pidx) {
    if (pidx < 256) return ML + b * 256 + (dir ? 255 - pidx : pidx);
    const int t = pidx - 256; return b * 2048 + (dir ? 2047 - t : t);
}

template <int MIX>
__device__ __forceinline__ void scan_item(int l, int sub, LAS unsigned char* lds) {
    const PView p(lds);
    const int tid = fresh_tid(), lane = tid & 63, wave = __builtin_amdgcn_readfirstlane(tid >> 6);
    const int dir = sub & 1, h = (sub >> 1) & 3, b = sub >> 3;
    const bf16* Z = (const bf16*)(p.ws + WS_Z);
    const bf16* Qsrc = Z + (MIX ? C_HQ : C_RQ) + h * 128;
    const int q_ld = PROJ;
    const bf16* Ksrc = MIX ? (Z + C_HF + dir * 512 + h * 128) : (Z + C_RK + h * 128);
    const int k_ld = PROJ;
    const bf16* Vsrc = Z + (MIX ? C_HI : C_RV) + h * 128;
    bf16* OS = (bf16*)(p.ws + WS_OS) + (size_t)(MIX * 2 + dir) * M * 512 + h * 128;
    const bool incl = MIX ? true : (dir == 0);

    LAS bf16* Qt = (LAS bf16*)(lds + SC_QT); LAS bf16* Qh = (LAS bf16*)(lds + SC_QH); LAS bf16* Kt = (LAS bf16*)(lds + SC_KT);
    LAS bf16* KhT = (LAS bf16*)(lds + SC_KHT); LAS bf16* VT = (LAS bf16*)(lds + SC_VT); LAS bf16* P = (LAS bf16*)(lds + SC_P);
    LAS float* subt = (LAS float*)(lds + SC_SUB); LAS float* dl = (LAS float*)(lds + SC_DL);

    const int d = tid & 127, I = tid >> 7;
    float lbv = 0.f, lgv = 0.f;
    if (MIX) lbv = ((const float*)(p.ws + WS_LOWER))[dir * 2048 + l * 512 + h * 128 + d];
    else { const float dz = p.in(I_RDEC)[l * 8 + dir * 4 + h]; lgv = fminf(dz, 0.f) - log1pf(__expf(-fabsf(dz))); }

    for (int i = tid; i < (9216 / 4); i += 512) ((LAS unsigned*)P)[i] = 0u;
    if (!MIX && tid < 65) dl[tid] = __builtin_amdgcn_exp2f((float)tid * lgv * 1.4426950408889634f);
    f32x4 sacc[8];
#pragma unroll
    for (int i = 0; i < 8; ++i) sacc[i] = (f32x4){0.f, 0.f, 0.f, 0.f};

    const int sj = tid & 63, sseg = tid >> 6;
    u32x4 pq0, pq1, pk0, pk1, pv0, pv1;
#define SCAN_LOAD_CHUNK(n_) do { const int row_ = scan_row0(b, dir, (n_)) + rstep * sj; \
        const bf16* q_ = Qsrc + (size_t)row_ * q_ld + 16 * sseg; pq0 = *(const u32x4*)q_; pq1 = *(const u32x4*)(q_ + 8); \
        const bf16* k_ = Ksrc + (size_t)row_ * k_ld + 16 * sseg; pk0 = *(const u32x4*)k_; pk1 = *(const u32x4*)(k_ + 8); \
        const bf16* v_ = Vsrc + (size_t)row_ * PROJ + 16 * sseg; pv0 = *(const u32x4*)v_; pv1 = *(const u32x4*)(v_ + 8); } while (0)
    const int rstep = dir ? -1 : 1;
    SCAN_LOAD_CHUNK(0);
    __syncthreads();
    const int r16 = lane & 15, q4 = lane >> 4;

    if constexpr (MIX == 0) {
    for (int n = 0; n < 36; ++n) {
        const int orow0 = scan_row0(b, dir, n);
        *(LAS u32x4*)(Qt + sj * 136 + 16 * sseg) = pq0; *(LAS u32x4*)(Qt + sj * 136 + 16 * sseg + 8) = pq1;
        *(LAS u32x4*)(Qh + sj * 136 + 16 * sseg) = pk0; *(LAS u32x4*)(Qh + sj * 136 + 16 * sseg + 8) = pk1;
        { const float g = dl[63 - sj]; float kv[8]; LAS bf16* kt = KhT + (16 * sseg) * 72 + sj;
          unpack8(pk0, kv);
#pragma unroll
          for (int i = 0; i < 8; ++i) kt[i * 72] = (bf16)f2bf(kv[i] * g);
          unpack8(pk1, kv);
#pragma unroll
          for (int i = 0; i < 8; ++i) kt[(8 + i) * 72] = (bf16)f2bf(kv[i] * g); }
        { LAS bf16* vt = VT + (16 * sseg) * 72 + sj;
          vt[0] = (bf16)(pv0.x & 0xffffu); vt[72] = (bf16)(pv0.x >> 16); vt[144] = (bf16)(pv0.y & 0xffffu); vt[216] = (bf16)(pv0.y >> 16);
          vt[288] = (bf16)(pv0.z & 0xffffu); vt[360] = (bf16)(pv0.z >> 16); vt[432] = (bf16)(pv0.w & 0xffffu); vt[504] = (bf16)(pv0.w >> 16);
          vt[576] = (bf16)(pv1.x & 0xffffu); vt[648] = (bf16)(pv1.x >> 16); vt[720] = (bf16)(pv1.y & 0xffffu); vt[792] = (bf16)(pv1.y >> 16);
          vt[864] = (bf16)(pv1.z & 0xffffu); vt[936] = (bf16)(pv1.z >> 16); vt[1008] = (bf16)(pv1.w & 0xffffu); vt[1080] = (bf16)(pv1.w >> 16); }
        if (n + 1 < 36) SCAN_LOAD_CHUNK(n + 1);
        __syncthreads();
#pragma unroll
        for (int rep = 0; rep < 2; ++rep) {
            const int tIdx = wave + 8 * rep;
            if (tIdx < 10) {
                const int Ip = (tIdx < 1) ? 0 : (tIdx < 3) ? 1 : (tIdx < 6) ? 2 : 3;
                const int J = tIdx - ((Ip * (Ip + 1)) >> 1);
                f32x4 a = (f32x4){0.f, 0.f, 0.f, 0.f};
                a = mma16<4>(Qh + (16 * J) * 136, 136, Qt + (16 * Ip) * 136, 136, a, lane);
                float pv[4];
#pragma unroll
                for (int r = 0; r < 4; ++r) {
                    const int dij = 16 * (Ip - J) + r16 - 4 * q4 - r;
                    const bool keep = incl ? (dij >= 0) : (dij > 0);
                    pv[r] = keep ? a[r] * dl[max(dij, 0)] : 0.f;
                }
                { u32x2 w; w.x = pk2(pv[0], pv[1]); w.y = pk2(pv[2], pv[3]); *(LAS u32x2*)(P + (16 * Ip + r16) * 72 + 16 * J + 4 * q4) = w; }
            }
        }
        bf16x8 sfr[4];
#pragma unroll
        for (int ks = 0; ks < 4; ++ks) { u32x4 w; w.x = pk2(sacc[2 * ks][0], sacc[2 * ks][1]); w.y = pk2(sacc[2 * ks][2], sacc[2 * ks][3]); w.z = pk2(sacc[2 * ks + 1][0], sacc[2 * ks + 1][1]); w.w = pk2(sacc[2 * ks + 1][2], sacc[2 * ks + 1][3]);
            sfr[ks] = __builtin_bit_cast(bf16x8, w); }
        __syncthreads();
#pragma unroll
        for (int it = 0; it < 4; ++it) {
            f32x4 o = (f32x4){0.f, 0.f, 0.f, 0.f}, ox = o;
            o = mma16<2>(VT + (16 * wave) * 72, 72, P + (16 * it) * 72, 72, o, lane);
            const LAS bf16* qh = Qt + (16 * it + r16) * 136 + 4 * q4;
#pragma unroll
            for (int ks = 0; ks < 4; ++ks) {
                const u32x2 a0 = *(const LAS u32x2*)(qh + 32 * ks), a1 = *(const LAS u32x2*)(qh + 32 * ks + 16);
                u32x4 aw; aw.x = a0.x; aw.y = a0.y; aw.z = a1.x; aw.w = a1.y;
                ox = __builtin_amdgcn_mfma_f32_16x16x32_bf16(sfr[ks], __builtin_bit_cast(bf16x8, aw), ox, 0, 0, 0);
            }
            { const int i = 16 * it + r16; const float gi = dl[i + 1];
              u32x2 w; w.x = pk2(o[0] + gi * ox[0], o[1] + gi * ox[1]); w.y = pk2(o[2] + gi * ox[2], o[3] + gi * ox[3]);
              *(u32x2*)(OS + (size_t)(orow0 + rstep * i) * 512 + 16 * wave + 4 * q4) = w; }
        }
        { const float g64 = dl[64];
#pragma unroll
          for (int dt = 0; dt < 8; ++dt) sacc[dt] = mma16<2>(KhT + (16 * dt) * 72, 72, VT + (16 * wave) * 72, 72, sacc[dt] * g64, lane); }
        __syncthreads();
    }
    } else {
    for (int n = 0; n < 36; ++n) {
        const int orow0 = scan_row0(b, dir, n);
        *(LAS u32x4*)(Qt + sj * 136 + 16 * sseg) = pq0; *(LAS u32x4*)(Qt + sj * 136 + 16 * sseg + 8) = pq1;
        *(LAS u32x4*)(Qh + sj * 136 + 16 * sseg) = pk0; *(LAS u32x4*)(Qh + sj * 136 + 16 * sseg + 8) = pk1;
        { LAS bf16* vt = VT + (16 * sseg) * 72 + sj;
          vt[0] = (bf16)(pv0.x & 0xffffu); vt[72] = (bf16)(pv0.x >> 16); vt[144] = (bf16)(pv0.y & 0xffffu); vt[216] = (bf16)(pv0.y >> 16);
          vt[288] = (bf16)(pv0.z & 0xffffu); vt[360] = (bf16)(pv0.z >> 16); vt[432] = (bf16)(pv0.w & 0xffffu); vt[504] = (bf16)(pv0.w >> 16);
          vt[576] = (bf16)(pv1.x & 0xffffu); vt[648] = (bf16)(pv1.x >> 16); vt[720] = (bf16)(pv1.y & 0xffffu); vt[792] = (bf16)(pv1.y >> 16);
          vt[864] = (bf16)(pv1.z & 0xffffu); vt[936] = (bf16)(pv1.z >> 16); vt[1008] = (bf16)(pv1.w & 0xffffu); vt[1080] = (bf16)(pv1.w >> 16); }
        if (n + 1 < 36) SCAN_LOAD_CHUNK(n + 1);
        __syncthreads();
        float c[16], q[16], key[16];
        {
            float run = 0.f;
#pragma unroll
            for (int jj = 0; jj < 16; ++jj) {
                q[jj] = bf2f(Qt[(16 * I + jj) * 136 + d]);
                const float kr = bf2f(Qh[(16 * I + jj) * 136 + d]);
                float lf;
                if (MIX) { q[jj] = siluf_(q[jj]); const float ez = __expf(-fminf(fmaxf(kr, -30.f), 30.f));
                    const float sg = 1.0f / (1.0f + ez); const float f = lbv + (1.0f - lbv) * sg;
                    lf = __logf(f); key[jj] = (1.0f - lbv) * (ez * sg); }
                else { lf = lgv; key[jj] = kr; }
                run += lf; c[jj] = run;
            }
            subt[I * 128 + d] = run;
        }
        __syncthreads();
        {
            const float t0 = subt[d], t1 = subt[128 + d], t2 = subt[256 + d], t3 = subt[384 + d];
            const float ref1 = t0, ref2 = t0 + t1, ref3 = ref2 + t2, tot = ref3 + t3;
            const float pre = (I == 0) ? 0.f : (I == 1) ? ref1 : (I == 2) ? ref2 : ref3;
            if (I == 0) dl[d] = __expf(tot);
            const float Epre = __expf(pre), Etp = __expf(tot - pre);
            const float Er1 = __expf(ref1 - pre), Er2 = __expf(ref2 - pre), Er3 = __expf(ref3 - pre);
            unsigned khp[8];
#pragma unroll
            for (int jj = 0; jj < 16; ++jj) {
                const int j = 16 * I + jj;
                const float qt = q[jj] * __expf(c[jj]);
                const float kd = key[jj] * __expf(fminf(-c[jj], 80.f));
                Qt[j * 136 + d] = (bf16)f2bf(qt);
                Qh[j * 136 + d] = (bf16)f2bf(qt * Epre);
                const unsigned khb = f2bf(kd * Etp);
                if (jj & 1) khp[jj >> 1] |= khb << 16; else khp[jj >> 1] = khb;
                Kt[(((I == 0) ? 0 : (I == 1) ? 16 : (I == 2) ? 48 : 96) + j) * 136 + d] = (bf16)f2bf(kd);
                if (I < 1) Kt[(16 + j) * 136 + d] = (bf16)f2bf(kd * Er1);
                if (I < 2) Kt[(48 + j) * 136 + d] = (bf16)f2bf(kd * Er2);
                if (I < 3) Kt[(96 + j) * 136 + d] = (bf16)f2bf(kd * Er3);
            }
            u32x4 w0, w1;
            w0.x = khp[0]; w0.y = khp[1]; w0.z = khp[2]; w0.w = khp[3]; w1.x = khp[4]; w1.y = khp[5]; w1.z = khp[6]; w1.w = khp[7];
            *(LAS u32x4*)(KhT + d * 72 + 16 * I) = w0; *(LAS u32x4*)(KhT + d * 72 + 16 * I + 8) = w1;
        }
        __syncthreads();
#pragma unroll
        for (int rep = 0; rep < 2; ++rep) {
            const int tIdx = wave + 8 * rep;
            if (tIdx < 10) {
                const int Ip = (tIdx < 1) ? 0 : (tIdx < 3) ? 1 : (tIdx < 6) ? 2 : 3;
                const int J = tIdx - ((Ip * (Ip + 1)) >> 1);
                const int kbase = (Ip == 0) ? 0 : (Ip == 1) ? 16 : (Ip == 2) ? 48 : 96;
                f32x4 a = (f32x4){0.f, 0.f, 0.f, 0.f};
                a = mma16<4>(Kt + (kbase + 16 * J) * 136, 136, Qt + (16 * Ip) * 136, 136, a, lane);
                float pv[4];
#pragma unroll
                for (int r = 0; r < 4; ++r) {
                    float v = a[r];
                    if (J == Ip) { const int jr = 4 * q4 + r; const bool keep = incl ? (jr <= r16) : (jr < r16); v = keep ? v : 0.f; }
                    pv[r] = v;
                }
                { u32x2 w; w.x = pk2(pv[0], pv[1]); w.y = pk2(pv[2], pv[3]); *(LAS u32x2*)(P + (16 * Ip + r16) * 72 + 16 * J + 4 * q4) = w; }
            }
        }
        bf16x8 sfr[4];
#pragma unroll
        for (int ks = 0; ks < 4; ++ks) { u32x4 w; w.x = pk2(sacc[2 * ks][0], sacc[2 * ks][1]); w.y = pk2(sacc[2 * ks][2], sacc[2 * ks][3]); w.z = pk2(sacc[2 * ks + 1][0], sacc[2 * ks + 1][1]); w.w = pk2(sacc[2 * ks + 1][2], sacc[2 * ks + 1][3]);
            sfr[ks] = __builtin_bit_cast(bf16x8, w); }
        __syncthreads();
#pragma unroll
        for (int it = 0; it < 4; ++it) {
            f32x4 o = (f32x4){0.f, 0.f, 0.f, 0.f};
            o = mma16<2>(VT + (16 * wave) * 72, 72, P + (16 * it) * 72, 72, o, lane);
            const LAS bf16* qh = Qh + (16 * it + r16) * 136 + 4 * q4;
#pragma unroll
            for (int ks = 0; ks < 4; ++ks) {
                const u32x2 a0 = *(const LAS u32x2*)(qh + 32 * ks), a1 = *(const LAS u32x2*)(qh + 32 * ks + 16);
                u32x4 aw; aw.x = a0.x; aw.y = a0.y; aw.z = a1.x; aw.w = a1.y;
                o = __builtin_amdgcn_mfma_f32_16x16x32_bf16(sfr[ks], __builtin_bit_cast(bf16x8, aw), o, 0, 0, 0);
            }
            { const int i = 16 * it + r16;
              u32x2 w; w.x = pk2(o[0], o[1]); w.y = pk2(o[2], o[3]);
              *(u32x2*)(OS + (size_t)(orow0 + rstep * i) * 512 + 16 * wave + 4 * q4) = w; }
        }
#pragma unroll
        for (int dt = 0; dt < 8; ++dt) {
            const f32x4 dv = *(const LAS f32x4*)(dl + 16 * dt + 4 * q4);
            sacc[dt] = mma16<2>(KhT + (16 * dt) * 72, 72, VT + (16 * wave) * 72, 72, sacc[dt] * dv, lane);
        }
        __syncthreads();
    }
    }
#undef SCAN_LOAD_CHUNK
}

constexpr int AT_Q = 0, AT_K = 36864, AT_V = 55296, AT_RPB = 73728, AT_END = 75776;
typedef short s16x4 __attribute__((ext_vector_type(4)));
template <bool NA>
__device__ __forceinline__ void attn_unit(int l, int kind, int sub, LAS unsigned char* lds) {
    const PView p(lds);
    const int tid = fresh_tid(), lane = tid & 63, wave = __builtin_amdgcn_readfirstlane(tid >> 6);
    const bf16* Z = (const bf16*)(p.ws + WS_Z);
    constexpr bool na = NA; const bool lat = (kind & 1) == 0;
    int b, hh, qt = 0;
    if (lat) { qt = sub & 7; hh = (sub >> 3) & 7; b = sub >> 6; } else { hh = sub & 7; b = sub >> 3; }
    const bf16* Qp; const bf16* Kp; const bf16* Vp; int q_ld, k_ld;
    if (na) { Qp = Z + C_NQ + hh * 64; q_ld = PROJ; Kp = Z + C_NK + hh * 64; k_ld = PROJ; Vp = Z + C_NV + hh * 64; }
    else { Qp = Z + C_GQ + hh * 64; q_ld = PROJ; Kp = (const bf16*)(p.ws + WS_GK) + (hh >> 2) * 64; k_ld = 128; Vp = Z + C_GV + (hh >> 2) * 64; }
    bf16* Op = (bf16*)(p.ws + WS_OB) + (size_t)(na ? 2 : 3) * M * 512 + hh * 64;
    const int q_row0 = lat ? (b * 2048 + 256 * qt) : (ML + b * 256);
    int nloc = 0, lat_row0 = b * 2048, R0 = 0;
    if (lat) { if (na) { const int r0 = 4 * qt, r1 = 4 * qt + 3; R0 = min(max(r0 - 4, 0), 24); nloc = min(max(r1 - 4, 0), 24) + 8 - R0; lat_row0 = b * 2048 + 64 * R0; } else nloc = 32; }
    const int ntile = nloc + 4, ctx_row0 = ML + b * 256;

    LAS bf16* Qs = (LAS bf16*)(lds + AT_Q); LAS bf16* Ks = (LAS bf16*)(lds + AT_K); LAS bf16* Vs = (LAS bf16*)(lds + AT_V); LAS float* rpb = (LAS float*)(lds + AT_RPB);
    constexpr float LOG2E = 1.4426950408889634f;
    const float gq_shift = ((const float*)(p.ws + WS_GQB))[l];

    { const int row = tid >> 1, seg = tid & 1; const bf16* src = Qp + (size_t)(q_row0 + row) * q_ld + 32 * seg;
      u32x4 a0 = *(const u32x4*)src, a1 = *(const u32x4*)(src + 8), a2 = *(const u32x4*)(src + 16), a3 = *(const u32x4*)(src + 24);
      if (!na) {
          float x[32]; { float t8[8]; unpack8(a0, t8);
#pragma unroll
              for (int j = 0; j < 8; ++j) x[j] = t8[j];
              unpack8(a1, t8);
#pragma unroll
              for (int j = 0; j < 8; ++j) x[8 + j] = t8[j];
              unpack8(a2, t8);
#pragma unroll
              for (int j = 0; j < 8; ++j) x[16 + j] = t8[j];
              unpack8(a3, t8);
#pragma unroll
              for (int j = 0; j < 8; ++j) x[24 + j] = t8[j]; }
          float ss = 0.f;
#pragma unroll
          for (int j = 0; j < 32; ++j) ss += x[j] * x[j];
          ss += shx(ss, 1, lane);
          const float rinv = 1.0f / sqrtf(ss * (1.0f / 64.0f) + NORM_EPS);
          const float* gn = p.in(I_QNG) + l * 64 + 32 * seg;
#pragma unroll
          for (int j = 0; j < 32; ++j) x[j] = x[j] * rinv * gn[j];
          if (lat) { const int tq = 256 * qt + row; const int pos = seg ? (tq & 63) : (tq >> 6);
              const float* tb = (const float*)(p.ws + WS_ROPEB) + pos * 32;
#pragma unroll
              for (int j = 0; j < 16; ++j) { const float cs = tb[2 * j], sn = tb[2 * j + 1], x1 = x[j], x2 = x[16 + j]; x[j] = x1 * cs - x2 * sn; x[16 + j] = x1 * sn + x2 * cs; } }
#pragma unroll
          for (int j = 0; j < 32; ++j) x[j] *= 0.125f * LOG2E;
          a0.x = pk2(x[0], x[1]); a0.y = pk2(x[2], x[3]); a0.z = pk2(x[4], x[5]); a0.w = pk2(x[6], x[7]);
          a1.x = pk2(x[8], x[9]); a1.y = pk2(x[10], x[11]); a1.z = pk2(x[12], x[13]); a1.w = pk2(x[14], x[15]);
          a2.x = pk2(x[16], x[17]); a2.y = pk2(x[18], x[19]); a2.z = pk2(x[20], x[21]); a2.w = pk2(x[22], x[23]);
          a3.x = pk2(x[24], x[25]); a3.y = pk2(x[26], x[27]); a3.z = pk2(x[28], x[29]); a3.w = pk2(x[30], x[31]);
      }
      LAS bf16* dst = Qs + row * 72 + 32 * seg;
      *(LAS u32x4*)dst = a0; *(LAS u32x4*)(dst + 8) = a1; *(LAS u32x4*)(dst + 16) = a2; *(LAS u32x4*)(dst + 24) = a3; }
    if (na && lat) { const float* rp = p.in(I_RPB) + (size_t)(l * 8 + hh) * 465; for (int i = tid; i < 465; i += 512) rpb[i] = rp[i] * LOG2E; }

    u32x4 kreg, vreg;
    const int krow = tid >> 3, kseg = tid & 7;
#define ATT_LOAD_TILE(kt_) do { const int row0_ = ((kt_) < nloc) ? (lat_row0 + 64 * (kt_)) : (ctx_row0 + 64 * ((kt_) - nloc)); \
        kreg = *(const u32x4*)(Kp + (size_t)(row0_ + krow) * k_ld + 8 * kseg); vreg = *(const u32x4*)(Vp + (size_t)(row0_ + krow) * PROJ + 8 * kseg); } while (0)
#define ATT_STORE_TILE(buf_) do { *(LAS u32x4*)(Ks + (buf_) * 4608 + krow * 72 + 8 * kseg) = kreg; *(LAS u32x4*)(Vs + (buf_) * 4608 + krow * 72 + 8 * kseg) = vreg; } while (0)
    ATT_LOAD_TILE(0);
    ATT_STORE_TILE(0);
    ATT_LOAD_TILE(1);
    __syncthreads();

    const int r16 = lane & 15, q4 = lane >> 4;
    bf16x8 qf[2][2];
    int w0[2], c0[2], rqv[2], cqv[2];
    float m_run[2], l_run[2];
    f32x4 o[2][4];
#pragma unroll
    for (int c = 0; c < 2; ++c) {
        const int qi = 32 * wave + 16 * c + r16;
        qf[c][0] = *(const LAS bf16x8*)(Qs + qi * 72 + 8 * q4); qf[c][1] = *(const LAS bf16x8*)(Qs + qi * 72 + 32 + 8 * q4);
        rqv[c] = 4 * qt + (qi >> 6); cqv[c] = qi & 63; w0[c] = min(max(rqv[c] - 4, 0), 24); c0[c] = min(max(cqv[c] - 8, 0), 48);
        m_run[c] = -INFINITY; l_run[c] = 0.f;
#pragma unroll
        for (int r = 0; r < 4; ++r) o[c][r] = (f32x4){0.f, 0.f, 0.f, 0.f};
    }
    const int koff = r16 * 72 + 8 * q4;
    const int voff = (4 * q4 + (r16 >> 2)) * 72 + 4 * (r16 & 3);
    const float si_ = na ? 0.f : -gq_shift; const f32x4 sinit = (f32x4){si_, si_, si_, si_};
    const bf16x8 ones = (bf16x8){0x3f80, 0x3f80, 0x3f80, 0x3f80, 0x3f80, 0x3f80, 0x3f80, 0x3f80};
    f32x4 lacc[2] = {(f32x4){0.f, 0.f, 0.f, 0.f}, (f32x4){0.f, 0.f, 0.f, 0.f}};

    for (int kt = 0; kt < ntile; ++kt) {
        const int cur = kt & 1;
        if (kt + 1 < ntile) { ATT_STORE_TILE(cur ^ 1); if (kt + 2 < ntile) ATT_LOAD_TILE(kt + 2); }
        const LAS bf16* Kb = Ks + cur * 4608; const LAS bf16* Vb = Vs + cur * 4608;
        const int w0w = min(max(4 * qt + (wave >> 1) - 4, 0), 24);
        if (!(na && kt < nloc && (R0 + kt < w0w || R0 + kt >= w0w + 8))) {
        f32x4 s[2][4];
#pragma unroll
        for (int jt = 0; jt < 4; ++jt) {
            const bf16x8 k0 = *(const LAS bf16x8*)(Kb + 16 * jt * 72 + koff), k1 = *(const LAS bf16x8*)(Kb + 16 * jt * 72 + koff + 32);
#pragma unroll
            for (int c = 0; c < 2; ++c) {
                s[c][jt] = __builtin_amdgcn_mfma_f32_16x16x32_bf16(k0, qf[c][0], sinit, 0, 0, 0);
                s[c][jt] = __builtin_amdgcn_mfma_f32_16x16x32_bf16(k1, qf[c][1], s[c][jt], 0, 0, 0);
            }
        }
        const bool local = na && (kt < nloc);
        const int kr = R0 + kt;
        bf16x8 pf[2][2];
#pragma unroll
        for (int c = 0; c < 2; ++c) {
            constexpr float SC = 0.125f * LOG2E;
            if (!na) {
#pragma unroll
                for (int jt = 0; jt < 4; ++jt)
#pragma unroll
                    for (int r = 0; r < 4; ++r) s[c][jt][r] = __builtin_amdgcn_exp2f(s[c][jt][r]);
            } else {
            float tm = -INFINITY;
            if (local) {
                const bool rowok = (kr >= w0[c]) && (kr < w0[c] + 8);
#pragma unroll
                for (int jt = 0; jt < 4; ++jt)
#pragma unroll
                    for (int r = 0; r < 4; ++r) {
                        const int kc = 16 * jt + 4 * q4 + r; const bool ok = rowok && (kc >= c0[c]) && (kc < c0[c] + 16);
                        const int bi = min(max((kr - rqv[c] + 7) * 31 + (kc - cqv[c] + 15), 0), 464);
                        const float v = ok ? __builtin_fmaf(s[c][jt][r], SC, rpb[bi]) : -INFINITY;
                        s[c][jt][r] = v; tm = fmaxf(tm, v);
                    }
            } else {
#pragma unroll
                for (int jt = 0; jt < 4; ++jt) tm = fmaxf(fmaxf(tm, fmaxf(s[c][jt][0], s[c][jt][1])), fmaxf(s[c][jt][2], s[c][jt][3]));
                tm *= SC;
            }
            tm = fmaxf(tm, shx(tm, 16, lane)); tm = fmaxf(tm, shx(tm, 32, lane));
            const float mn = fmaxf(m_run[c], tm), mu = (mn == -INFINITY) ? 0.f : mn;
            const float alpha = __builtin_amdgcn_exp2f(m_run[c] - mu);
            float ps = 0.f;
            if (local) {
#pragma unroll
                for (int jt = 0; jt < 4; ++jt)
#pragma unroll
                    for (int r = 0; r < 4; ++r) { const float pv = __builtin_amdgcn_exp2f(s[c][jt][r] - mu); s[c][jt][r] = pv; ps += pv; }
            } else {
#pragma unroll
                for (int jt = 0; jt < 4; ++jt)
#pragma unroll
                    for (int r = 0; r < 4; ++r) { const float pv = __builtin_amdgcn_exp2f(__builtin_fmaf(s[c][jt][r], SC, -mu)); s[c][jt][r] = pv; ps += pv; }
            }
            l_run[c] = l_run[c] * alpha + ps; m_run[c] = mn;
#pragma unroll
            for (int et = 0; et < 4; ++et) o[c][et] = o[c][et] * alpha;
            }
#pragma unroll
            for (int kk = 0; kk < 2; ++kk) { u32x4 w; w.x = pk2(s[c][2 * kk][0], s[c][2 * kk][1]); w.y = pk2(s[c][2 * kk][2], s[c][2 * kk][3]); w.z = pk2(s[c][2 * kk + 1][0], s[c][2 * kk + 1][1]); w.w = pk2(s[c][2 * kk + 1][2], s[c][2 * kk + 1][3]);
                pf[c][kk] = __builtin_bit_cast(bf16x8, w);
                if (!na) lacc[c] = __builtin_amdgcn_mfma_f32_16x16x32_bf16(ones, pf[c][kk], lacc[c], 0, 0, 0); }
        }
#pragma unroll
        for (int et = 0; et < 4; ++et)
#pragma unroll
            for (int kk = 0; kk < 2; ++kk) {
                const s16x4 va = __builtin_amdgcn_ds_read_tr16_b64_v4i16((LAS s16x4*)(Vb + (32 * kk) * 72 + 16 * et + voff));
                const s16x4 vb = __builtin_amdgcn_ds_read_tr16_b64_v4i16((LAS s16x4*)(Vb + (32 * kk + 16) * 72 + 16 * et + voff));
                const bf16x8 vf = __builtin_shufflevector(va, vb, 0, 1, 2, 3, 4, 5, 6, 7);
                o[0][et] = __builtin_amdgcn_mfma_f32_16x16x32_bf16(vf, pf[0][kk], o[0][et], 0, 0, 0);
                o[1][et] = __builtin_amdgcn_mfma_f32_16x16x32_bf16(vf, pf[1][kk], o[1][et], 0, 0, 0);
            }
        }
        __syncthreads();
        __syncthreads();
    }
#undef ATT_LOAD_TILE
#undef ATT_STORE_TILE
#pragma unroll
    for (int c = 0; c < 2; ++c) {
        float lt;
        if (!na) lt = lacc[c][0];
        else { lt = l_run[c]; lt += shx(lt, 16, lane); lt += shx(lt, 32, lane); }
        const float inv = 1.0f / lt;
        bf16* orow = Op + (size_t)(q_row0 + 32 * wave + 16 * c + r16) * 512 + 4 * q4;
#pragma unroll
        for (int et = 0; et < 4; ++et) { u32x2 w; w.x = pk2(o[c][et][0] * inv, o[c][et][1] * inv); w.y = pk2(o[c][et][2] * inv, o[c][et][3] * inv); *(u32x2*)(orow + 16 * et) = w; }
    }
}

constexpr int Q_GL = 512, Q_GC = 64, Q_NL = 512, Q_NC = 64, Q_ATT = Q_GL + Q_GC + Q_NL + Q_NC;
__device__ __forceinline__ int queue_pop(unsigned* head, LAS unsigned char* lds) {
    volatile LAS int* misc = (volatile LAS int*)(lds + MISC_OFF);
    __syncthreads();
    if (threadIdx.x == 0) misc[4] = (int)__hip_atomic_fetch_add(head, 1u, __ATOMIC_RELAXED, __HIP_MEMORY_SCOPE_AGENT);
    __syncthreads();
    return __builtin_amdgcn_readfirstlane(misc[4]);
}
template <int REP_SCAN, int REP_ATT>
__device__ __forceinline__ void phase_mixers(int l, LAS unsigned char* lds, int qoff) {
    unsigned* qhead; { const PView p(lds); qhead = (unsigned*)(p.ws + WS_CTL) + CW_QUEUE + 512 * l + qoff; }
    for (;;) { const int item = queue_pop(qhead + 64, lds); if (item >= 64 * REP_SCAN) break; scan_item<1>(l, item & 63, lds); }
    for (;;) { const int item = queue_pop(qhead, lds); if (item >= 64 * REP_SCAN) break; scan_item<0>(l, item & 63, lds); }
    for (;;) {
        const int item = queue_pop(qhead + 192, lds); if (item >= pg8::INPROJ_DEFER) break;
        const PView pv(lds); unsigned char* ws = pv.ws;
        pg8::Gemm g{(const pg8::bf16_t*)(ws + WS_H), (const pg8::bf16_t*)(ws + WS_WIN) + (size_t)l * PROJ * 1024, M, PROJ, 1024};
        pg8::SingleUnit S{item, 42};
        pg8::EpiZ E{(pg8::bf16_t*)(ws + WS_Z), PROJ, (const float*)(ws + WS_ROPEA)};
        pg8::gemm_phase<pg8::EpiZ, pg8::SingleUnit, true, true>(lds, g, S, E);
    }
    for (;;) {
        int item = queue_pop(qhead + 128, lds); if (item >= (Q_GL + Q_GC) * REP_ATT) break;
        if (REP_ATT > 1) item %= (Q_GL + Q_GC);
        const bool cx = item >= Q_GL; attn_unit<false>(l, cx ? 1 : 0, cx ? item - Q_GL : item, lds);
    }
    for (;;) {
        int item = queue_pop(qhead + 256, lds); if (item >= (Q_NL + Q_NC) * REP_ATT) break;
        if (REP_ATT > 1) item %= (Q_NL + Q_NC);
        const bool cx = item >= Q_NL; attn_unit<true>(l, cx ? 3 : 2, cx ? item - Q_NL : item, lds);
    }
}

__device__ __forceinline__ void phase_postscan(LAS unsigned char* lds, int l) {
    const PView p(lds); const int tid = fresh_tid();
    const int lane = tid & 63, gw = fresh_blk() * 8 + (tid >> 6), NGW = fresh_grid() * 8;
    const bf16* Z = (const bf16*)(p.ws + WS_Z); const bf16* OS = (const bf16*)(p.ws + WS_OS); bf16* OB = (bf16*)(p.ws + WS_OB);
    const float* gng = p.in(I_RGNG) + l * 512 + 8 * lane; const float* gnb = p.in(I_RGNB) + l * 512 + 8 * lane; const float* hng = p.in(I_HNG) + l * 512 + 8 * lane;
    constexpr int R = 3;
    for (int row0 = gw; row0 < M; row0 += R * NGW) {
        u32x4 ld[R][2][2]; u32x4 gr[R][2];
#pragma unroll
        for (int k = 0; k < R; ++k) { const int row = min(row0 + k * NGW, M - 1);
#pragma unroll
            for (int mix = 0; mix < 2; ++mix) {
                const bf16* a = OS + ((size_t)(mix * 2) * M + row) * 512 + 8 * lane;
                ld[k][mix][0] = *(const u32x4*)a; ld[k][mix][1] = *(const u32x4*)(a + (size_t)M * 512);
                gr[k][mix] = *(const u32x4*)(Z + (size_t)row * PROJ + (mix ? C_HG : C_RG) + 8 * lane); } }
#pragma unroll
        for (int k = 0; k < R; ++k) { const int row = row0 + k * NGW;
#pragma unroll
            for (int mix = 0; mix < 2; ++mix) {
                float o[8], ob[8]; unpack8(ld[k][mix][0], o); unpack8(ld[k][mix][1], ob);
#pragma unroll
                for (int j = 0; j < 8; ++j) o[j] += ob[j];
                float g[8]; unpack8(gr[k][mix], g);
                float y[8];
                if (mix == 0) {
                    float s = 0.f;
#pragma unroll
                    for (int j = 0; j < 8; ++j) s += o[j];
                    s += shx(s, 1, lane); s += shx(s, 2, lane); s += shx(s, 4, lane); s += shx(s, 8, lane);
                    const float mu = s * (1.0f / 128.0f); float s2 = 0.f;
#pragma unroll
                    for (int j = 0; j < 8; ++j) { o[j] -= mu; s2 += o[j] * o[j]; }
                    s2 += shx(s2, 1, lane); s2 += shx(s2, 2, lane); s2 += shx(s2, 4, lane); s2 += shx(s2, 8, lane);
                    const float rstd = 1.0f / sqrtf(s2 * (1.0f / 128.0f) + LN_EPS);
#pragma unroll
                    for (int j = 0; j < 8; ++j) y[j] = (o[j] * rstd * gng[j] + gnb[j]) * siluf_(g[j]);
                } else {
                    float s2 = 0.f;
#pragma unroll
                    for (int j = 0; j < 8; ++j) s2 += o[j] * o[j];
                    s2 += shx(s2, 1, lane); s2 += shx(s2, 2, lane); s2 += shx(s2, 4, lane); s2 += shx(s2, 8, lane);
                    const float rinv = 1.0f / sqrtf(s2 * (1.0f / 128.0f) + NORM_EPS);
#pragma unroll
                    for (int j = 0; j < 8; ++j) y[j] = o[j] * rinv * hng[j] * siluf_(g[j]);
                }
                if (row < M) *(u32x4*)(OB + ((size_t)mix * M + row) * 512 + 8 * lane) = pack8(y);
            } }
    }
}

__device__ __forceinline__ void phase_gatesum(LAS unsigned char* lds, int Ml) {
    const PView p(lds); const int tid = fresh_tid();
    const u32x4* YB = (const u32x4*)(p.ws + WS_YB); u32x4* SB = (u32x4*)(p.ws + WS_SB); const bf16* Z = (const bf16*)(p.ws + WS_Z);
    constexpr size_t NV = (size_t)M * 1024 / 8; const size_t nv = (size_t)Ml * 128;
    constexpr int R = 2;
    const size_t stride = (size_t)fresh_grid() * 512;
    for (size_t i0 = (size_t)fresh_blk() * 512 + tid; i0 < nv; i0 += R * stride) {
        u32x4 va[R][4], ga[R][4];
#pragma unroll
        for (int k = 0; k < R; ++k) { const size_t i = (i0 + k * stride < nv) ? i0 + k * stride : i0; const size_t row = i >> 7; const int col = (int)(i & 127) * 8;
            const bf16* gz = Z + row * PROJ + C_GATE + col;
#pragma unroll
            for (int n = 0; n < 4; ++n) { va[k][n] = YB[i + n * NV]; ga[k][n] = *(const u32x4*)(gz + 1024 * n); } }
#pragma unroll
        for (int k = 0; k < R; ++k) { const size_t i = i0 + k * stride; if (i >= nv) break;
            float o[8];
#pragma unroll
            for (int j = 0; j < 8; ++j) o[j] = 0.f;
#pragma unroll
            for (int n = 0; n < 4; ++n) { float y[8], g[8]; unpack8(va[k][n], y); unpack8(ga[k][n], g);
#pragma unroll
                for (int j = 0; j < 8; ++j) o[j] += y[j] / (1.0f + __expf(-g[j])); }
            SB[i] = pack8(o); }
    }
}

__device__ __forceinline__ void phase_ln1_router(int l, LAS unsigned char* lds, bool to_dummy, int Ml) {
    const PView p(lds);
    const int tid = fresh_tid(), lane = tid & 63, wave = __builtin_amdgcn_readfirstlane(tid >> 6), blk = fresh_blk(), G = fresh_grid();
    bf16* X = (bf16*)(p.ws + WS_X); bf16* H = (bf16*)(p.ws + WS_H); bf16* HLO = (bf16*)(p.ws + WS_HLO);
    const float* modl = (const float*)(p.ws + WS_MODV) + (size_t)l * 9 * 6144;
    const float* lng = p.in(I_LNG) + (l * 2 + 0) * 1024; const float* lnb = p.in(I_LNB) + (l * 2 + 0) * 1024;
    int* topi = (int*)(p.ws + WS_TOPI); float* topg = (float*)(p.ws + WS_TOPG); int* hist = (int*)(p.ws + WS_HIST);
    LAS int* lh = (LAS int*)lds;
    const int rpb_ = Ml / G;
    if (tid < 32) lh[tid] = 0;
    constexpr int R = 3;
    for (int i0 = wave; i0 < rpb_; i0 += 8 * R) {
        f32x4 xv[R][4];
#pragma unroll
        for (int k = 0; k < R; ++k) { const int i = min(i0 + 8 * k, rpb_ - 1); row_load16b(X + (size_t)(blk * rpb_ + i) * 1024, lane, xv[k]); }
#pragma unroll
        for (int k = 0; k < R; ++k) { const int i = i0 + 8 * k; if (i >= rpb_) break;
            const int row = blk * rpb_ + i;
            row_ln(xv[k], lng, lnb, lane);
            row_store16b((to_dummy ? (bf16*)(p.ws + WS_SB32) : X) + (size_t)row * 1024, lane, xv[k]);
            const float* mv = modl + (size_t)row_seg(row) * 6144;
            { f32x4 hv_[4]; row_mod_store(xv[k], mv + 3072, mv + 4096, H + (size_t)row * 1024, lane, hv_); }
        }
    }
    asm volatile("s_waitcnt vmcnt(0)" ::: "memory");
    __syncthreads();
    const int ntile = (rpb_ + 15) >> 4;
    const int r16 = lane & 15, q4 = lane >> 4;
    LAS f32x4* part = (LAS f32x4*)(lds + 1024);
    {
        const bf16* wh = (const bf16*)(p.ws + WS_WRT) + (size_t)(l * 2) * 32 * 1024 + (size_t)r16 * 1024 + 8 * q4 + 128 * wave; const bf16* wl = wh + 32 * 1024;
        bf16x8 w0h[4], w0l[4], w1h[4], w1l[4];
#pragma unroll
        for (int ks = 0; ks < 4; ++ks) { w0h[ks] = *(const bf16x8*)(wh + 32 * ks); w0l[ks] = *(const bf16x8*)(wl + 32 * ks); w1h[ks] = *(const bf16x8*)(wh + 16 * 1024 + 32 * ks); w1l[ks] = *(const bf16x8*)(wl + 16 * 1024 + 32 * ks); }
#pragma unroll
        for (int t = 0; t < 5; ++t) if (t < ntile) {
            const bf16* ah = H + (size_t)(blk * rpb_ + 16 * t + r16) * 1024 + 8 * q4 + 128 * wave;
            f32x4 a0 = (f32x4){0.f, 0.f, 0.f, 0.f}, a1 = a0;
#pragma unroll
            for (int ks = 0; ks < 4; ++ks) { const bf16x8 xh = *(const bf16x8*)(ah + 32 * ks);
                a0 = __builtin_amdgcn_mfma_f32_16x16x32_bf16(xh, w0l[ks], a0, 0, 0, 0); a0 = __builtin_amdgcn_mfma_f32_16x16x32_bf16(xh, w0h[ks], a0, 0, 0, 0);
                a1 = __builtin_amdgcn_mfma_f32_16x16x32_bf16(xh, w1l[ks], a1, 0, 0, 0); a1 = __builtin_amdgcn_mfma_f32_16x16x32_bf16(xh, w1h[ks], a1, 0, 0, 0); }
            part[((wave * 5 + t) * 2 + 0) * 64 + lane] = a0; part[((wave * 5 + t) * 2 + 1) * 64 + lane] = a1;
        }
    }
    __syncthreads();
    if (wave < ntile) {
        f32x4 acc0 = (f32x4){0.f, 0.f, 0.f, 0.f}, acc1 = acc0;
#pragma unroll
        for (int w = 0; w < 8; ++w) { acc0 += part[((w * 5 + wave) * 2 + 0) * 64 + lane]; acc1 += part[((w * 5 + wave) * 2 + 1) * 64 + lane]; }
        const float* br = p.in(I_BR) + l * 32; const float b0 = br[r16], b1 = br[16 + r16];
#pragma unroll
        for (int r = 0; r < 4; ++r) {
            float v0 = acc0[r] + b0, v1 = acc1[r] + b1;
            float tv[4]; int ti[4];
#pragma unroll
            for (int k = 0; k < 4; ++k) {
                float bv; int bi; if (v1 > v0) { bv = v1; bi = 16 + r16; } else { bv = v0; bi = r16; }
#pragma unroll
                for (int o = 1; o < 16; o <<= 1) { const float ov = shx(bv, o, lane); const int oi = shx(bi, o, lane); if (ov > bv || (ov == bv && oi < bi)) { bv = ov; bi = oi; } }
                tv[k] = bv; ti[k] = bi; if (bi == r16) v0 = -INFINITY; if (bi == 16 + r16) v1 = -INFINITY;
            }
            const int rl = 16 * wave + 4 * q4 + r;
            if (r16 == 0 && rl < rpb_) {
                const int row = blk * rpb_ + rl;
                const float e1 = __expf(tv[1] - tv[0]), e2 = __expf(tv[2] - tv[0]), e3 = __expf(tv[3] - tv[0]); const float inv = 1.0f / (1.0f + e1 + e2 + e3);
                *(int4*)(topi + (size_t)row * 4) = make_int4(ti[0], ti[1], ti[2], ti[3]);
                *(float4*)(topg + (size_t)row * 4) = make_float4(inv, e1 * inv, e2 * inv, e3 * inv);
                atomicAdd((int*)&lh[ti[0]], 1); atomicAdd((int*)&lh[ti[1]], 1); atomicAdd((int*)&lh[ti[2]], 1); atomicAdd((int*)&lh[ti[3]], 1);
            }
        }
    }
    __syncthreads();
    if (tid < 32) hist[blk * 32 + tid] = lh[tid];
}

__device__ __forceinline__ void phase_moe_slots(LAS unsigned char* lds, int Ml) {
    const PView p(lds);
    const int tid = fresh_tid(), lane = tid & 63, wave = tid >> 6, blk = fresh_blk(), G = fresh_grid();
    const int* hist = (const int*)(p.ws + WS_HIST); const int* topi = (const int*)(p.ws + WS_TOPI); int* slot = (int*)(p.ws + WS_SLOT); int* tile_e = (int*)(p.ws + WS_TILEE);
    const bf16* H = (const bf16*)(p.ws + WS_H); bf16* HP = (bf16*)(p.ws + WS_HP);
    LAS int* tot = (LAS int*)lds;   LAS int* base = tot + 32; LAS int* startp = tot + 64; LAS int* sl = tot + 128;
    const int rpb_ = Ml / G;
    if (tid < 32) { int t = 0, mb = 0;
#pragma unroll 4
        for (int b2 = 0; b2 < G; ++b2) { const int c = hist[b2 * 32 + tid]; t += c; mb += (b2 < blk) ? c : 0; } tot[tid] = t; base[tid] = mb; }
    __syncthreads();
    if (tid == 0) { int s = 0;
#pragma unroll 1
        for (int e = 0; e < 32; ++e) { startp[e] = s; const int pad = ((tot[e] + 255) >> 8) << 8;
            if (blk == 0) {
#pragma unroll 1
                for (int t = s >> 8; t < ((s + pad) >> 8); ++t) tile_e[t] = e; }
            s += pad; }
        if (blk == 0) tile_e[320] = s >> 8; }
    __syncthreads();
    LAS int* ent = tot + 512;
    for (int i = tid; i < rpb_ * 4; i += 512) ent[i] = topi[(size_t)blk * rpb_ * 4 + i];
    __syncthreads();
    for (int i = tid; i < rpb_ * 4; i += 512) { const int e = ent[i]; int rank = 0;
        for (int j = 0; j < i; ++j) rank += (ent[j] == e) ? 1 : 0;
        const int sv = startp[e] + base[e] + rank; sl[i] = sv; slot[(size_t)blk * rpb_ * 4 + i] = sv; }
    __syncthreads();
    int* stok = (int*)(p.ws + WS_STOK);
    for (int i = tid; i < rpb_ * 4; i += 512) stok[sl[i]] = blk * rpb_ + (i >> 2);
    if (blk == 0) for (int e = 0; e < 32; ++e) { const int s0 = startp[e] + tot[e], s1 = startp[e] + (((tot[e] + 255) >> 8) << 8); for (int q = s0 + tid; q < s1; q += 512) stok[q] = 0; }
}

__device__ __forceinline__ void phase_ln2(LAS unsigned char* lds, int l, bool to_dummy, int Ml) {
    const PView p(lds); const int tid = fresh_tid();
    const int lane = tid & 63, gw = fresh_blk() * 8 + (tid >> 6), NGW = fresh_grid() * 8;
    bf16* X = (bf16*)(p.ws + WS_X); bf16* H = (bf16*)(p.ws + WS_H); const bf16* Y2 = (const bf16*)(p.ws + WS_Y2);
    const float* modv = (const float*)(p.ws + WS_MODV);
    const float* lng = p.in(I_LNG) + (l * 2 + 1) * 1024; const float* lnb = p.in(I_LNB) + (l * 2 + 1) * 1024;
    const int* slot = (const int*)(p.ws + WS_SLOT); const float* topg = (const float*)(p.ws + WS_TOPG);
    constexpr int R = 3;
    for (int row0 = gw; row0 < Ml; row0 += R * NGW) {
        int4 sl[R]; float4 gt[R];
#pragma unroll
        for (int k = 0; k < R; ++k) { const int row = min(row0 + k * NGW, Ml - 1); sl[k] = *(const int4*)(slot + (size_t)row * 4); gt[k] = *(const float4*)(topg + (size_t)row * 4); }
        u32x2 yw[R][4][4]; f32x4 xv[R][4];
#pragma unroll
        for (int k = 0; k < R; ++k) { const int row = min(row0 + k * NGW, Ml - 1); const int sls[4] = {sl[k].x, sl[k].y, sl[k].z, sl[k].w};
#pragma unroll
            for (int e = 0; e < 4; ++e) { const u32x2* yp = (const u32x2*)(Y2 + (size_t)sls[e] * 1024) + lane;
#pragma unroll
                for (int j = 0; j < 4; ++j) yw[k][e][j] = yp[64 * j]; }
            row_load16b(X + (size_t)row * 1024, lane, xv[k]); }
#pragma unroll
        for (int k = 0; k < R; ++k) { const int row = row0 + k * NGW; if (row >= Ml) break;
            const float gts[4] = {gt[k].x, gt[k].y, gt[k].z, gt[k].w};
            f32x4 y[4];
#pragma unroll
            for (int j = 0; j < 4; ++j) y[j] = (f32x4){0.f, 0.f, 0.f, 0.f};
#pragma unroll
            for (int e = 0; e < 4; ++e)
#pragma unroll
                for (int j = 0; j < 4; ++j) { const u32x2 w = yw[k][e][j]; y[j] += (f32x4){bf2f(w.x & 0xffffu), bf2f(w.x >> 16), bf2f(w.y & 0xffffu), bf2f(w.y >> 16)} * gts[e]; }
            const int s = row_seg(row); const float* g2 = modv + (size_t)(l * 9 + s) * 6144 + 5120;
            f32x4 v[4];
#pragma unroll
            for (int j = 0; j < 4; ++j) v[j] = xv[k][j] * DN_ALPHA + *((const f32x4*)g2 + lane + 64 * j) * y[j];
            row_ln(v, lng, lnb, lane);
            if (l < DEPTH - 1) {
                row_store16b((to_dummy ? (bf16*)(p.ws + WS_SB32) : X) + (size_t)row * 1024, lane, v);
                const float* mv = modv + (size_t)((l + 1) * 9 + s) * 6144; f32x4 hv[4];
                row_mod_store(v, mv, mv + 1024, H + (size_t)row * 1024, lane, hv);
            } else if (row < ML) row_store16(p.out + (size_t)row * 1024, lane, v);
        }
    }
}

constexpr int PH_PER_LAYER = 12, N_PHASES = 2 + DEPTH * PH_PER_LAYER;
__global__ void __launch_bounds__(512, 2) fwd_kernel(Params p) {
    extern __shared__ __attribute__((aligned(16))) unsigned char lds_raw[];
    LAS unsigned char* lds = (LAS unsigned char*)lds_raw;
    {
        const int tid = threadIdx.x;
        if (tid < 16) ((LAS unsigned*)(lds + MISC_OFF))[tid] = 0u;
        if (tid < 25) ((LAS unsigned long long*)(lds + PT_OFF))[tid] = (unsigned long long)p.in[tid];
        if (tid == 25) ((LAS unsigned long long*)(lds + PT_OFF))[25] = (unsigned long long)p.out;
        if (tid == 26) ((LAS unsigned long long*)(lds + PT_OFF))[26] = (unsigned long long)p.ws;
    }
    __syncthreads();
#if !MK_PER_PHASE
    { const PView pv(lds); const XcdBarrier b0 = xcd_barrier_post((unsigned*)(pv.ws + WS_CTL) + CW_BAR, (volatile LAS unsigned*)(lds + MISC_OFF + 32));
      if (threadIdx.x == 0) ((volatile LAS unsigned*)(lds + MISC_OFF))[12] = b0.x; }
    __syncthreads();
#define GRID_BAR() do { XcdBarrier b_; b_.bar = (unsigned*)((unsigned char*)(__attribute__((address_space(1))) unsigned char*)ld_ptr_bits(lds, PT_WS) + WS_CTL) + CW_BAR; b_.st = (volatile LAS unsigned*)(lds + MISC_OFF + 32); \
        b_.x = ((volatile LAS unsigned*)(lds + MISC_OFF))[12]; xcd_barrier(b_); } while (0)
#else
#define GRID_BAR() do {} while (0)
#endif
#if MK_PER_PHASE
    const int lo = p.ph_lo, hi = p.ph_hi;
#else
    constexpr int lo = 0, hi = N_PHASES;
#endif
#define IN(k) (lo <= (k) && (k) < hi)
#define SEAM(k) do { if (IN(k) && IN((k) + 1)) { GRID_BAR(); if (PROBE_DUP_MASK & (1 << 17)) GRID_BAR(); } } while (0)

    if (IN(0)) { for (int rep_ = 0; rep_ < ((PROBE_DUP_MASK >> 16) & 1) + 1; ++rep_) phase_prologue(lds); } SEAM(0);
    if (IN(1)) { phase_init_h(lds); } SEAM(1);
    for (int l = 0; l < DEPTH; ++l) {
        const int pb = 2 + l * PH_PER_LAYER;
        const int Ml = (l == DEPTH - 1) ? ML : M;
        if (IN(pb + 0)) { for (int rep_ = 0; rep_ < ((PROBE_DUP_MASK >> 0) & 1) + 1; ++rep_) {
            const PView pv(lds); unsigned char* ws = pv.ws; const int G = fresh_grid(), blk = fresh_blk();
            pg8::Gemm g{(const pg8::bf16_t*)(ws + WS_H), (const pg8::bf16_t*)(ws + WS_WIN) + (size_t)l * PROJ * 1024, M, PROJ, 1024};
            pg8::InProjOrder S; S.init(G, blk);
            pg8::EpiZ E{(pg8::bf16_t*)(ws + WS_Z), PROJ, (const float*)(ws + WS_ROPEA)};
            pg8::gemm_phase<pg8::EpiZ, pg8::InProjOrder, true, true>(lds, g, S, E);
        } } SEAM(pb + 0);
        if (IN(pb + 1)) { for (int rep_ = 0; rep_ < ((PROBE_DUP_MASK >> 1) & 1) + 1; ++rep_) { phase_prep(lds, l); } } SEAM(pb + 1);
        if (IN(pb + 2)) { phase_mixers<1 + ((PROBE_DUP_MASK >> 11) & 1), 1 + ((PROBE_DUP_MASK >> 12) & 1)>(l, lds, 0); convert_fill(lds, l >= 1 ? (l - 1) * CONV_PER_L + CONV_IN_END : 0, conv_done_ptr(lds, l, 0), fresh_grid()); } SEAM(pb + 2);
        if (IN(pb + 3)) { for (int rep_ = 0; rep_ < ((PROBE_DUP_MASK >> 3) & 1) + 1; ++rep_) { phase_postscan(lds, l); } if (l >= 1) convert_drain(lds, (l - 1) * CONV_PER_L + CONV_IN_END, (l - 1) * CONV_PER_L + CONV_BR_END); } SEAM(pb + 3);
        if (IN(pb + 4)) { for (int rep_ = 0; rep_ < ((PROBE_DUP_MASK >> 4) & 1) + 1; ++rep_) {
            const PView pv(lds); unsigned char* ws = pv.ws; const int G = fresh_grid(), blk = fresh_blk();
            pg8::Gemm g{(const pg8::bf16_t*)(ws + WS_OB), (const pg8::bf16_t*)(ws + WS_WBR) + (size_t)l * 4 * 1024 * 512, 4 * M, 4096, 512};
            pg8::BranchOrder S{G, blk, (Ml / 256) * 16};
            pg8::EpiBranch E{(pg8::bf16_t*)(ws + WS_YB)};
            pg8::gemm_phase<pg8::EpiBranch, pg8::BranchOrder, true, true>(lds, g, S, E);
            convert_fill(lds, l >= 1 ? (l - 1) * CONV_PER_L + CONV_BR_END : 0, conv_done_ptr(lds, l, 1), G);
        } } SEAM(pb + 4);
        if (IN(pb + 5)) { for (int rep_ = 0; rep_ < ((PROBE_DUP_MASK >> 5) & 1) + 1; ++rep_) phase_gatesum(lds, Ml); if (l >= 1) convert_drain(lds, (l - 1) * CONV_PER_L + CONV_BR_END, (l - 1) * CONV_PER_L + CONV_OUT_END); } SEAM(pb + 5);
        if (IN(pb + 6)) { for (int rep_ = ((PROBE_DUP_MASK >> 6) & 1) ? 0 : 1; rep_ < 2; ++rep_) {
            const PView pv(lds); unsigned char* ws = pv.ws; const int G = fresh_grid(), blk = fresh_blk();
            pg8::Gemm g{(const pg8::bf16_t*)(ws + WS_SB), (const pg8::bf16_t*)(ws + WS_WOUT) + (size_t)l * 1024 * 1024, M, 1024, 1024};
            pg8::StaticOrder S; S.init(Ml, 1024, G, blk);
            pg8::EpiOut E{(pg8::bf16_t*)(ws + WS_X), (const float*)(ws + WS_MODV) + (size_t)l * 9 * 6144, (pg8::bf16_t*)(ws + (rep_ == 0 ? WS_SB32 : WS_X))};
            pg8::gemm_phase<pg8::EpiOut, pg8::StaticOrder, true, true>(lds, g, S, E);
            convert_fill(lds, l >= 1 ? (l - 1) * CONV_PER_L + CONV_OUT_END : 0, conv_done_ptr(lds, l, 2), G);
        } } SEAM(pb + 6);
        if (IN(pb + 7)) {
#if PROBE_DUP_MASK & (1 << 18)
            phase_ln1_router(l, lds, true, Ml);
#endif
            phase_ln1_router(l, lds, false, Ml); } SEAM(pb + 7);
        if (IN(pb + 8)) { for (int rep_ = 0; rep_ < ((PROBE_DUP_MASK >> 7) & 1) + 1; ++rep_) { phase_moe_slots(lds, Ml); } if (l >= 1) convert_drain(lds, (l - 1) * CONV_PER_L + CONV_OUT_END, l * CONV_PER_L); } SEAM(pb + 8);
        if (IN(pb + 9)) { for (int rep_ = 0; rep_ < ((PROBE_DUP_MASK >> 8) & 1) + 1; ++rep_) {
            const PView pv(lds); unsigned char* ws = pv.ws; const int G = fresh_grid(), blk = fresh_blk();
            pg8::Gemm g{(const pg8::bf16_t*)(ws + WS_H), (const pg8::bf16_t*)(ws + WS_WGU) + (size_t)l * 32 * 2048 * 1024, NSLOT, 32 * 2048, 1024, (const int*)(ws + WS_STOK)};
            pg8::MoeOrder<8> S{G, blk, (const int*)(ws + WS_TILEE)};
            pg8::EpiGU E{(pg8::bf16_t*)(ws + WS_ACT), pv.in(I_BGU) + (size_t)l * 32 * 2048};
            pg8::gemm_phase<pg8::EpiGU, pg8::MoeOrder<8>, true, true, true>(lds, g, S, E);
            convert_fill(lds, l * CONV_PER_L, conv_done_ptr(lds, l, 3), G);
        } } SEAM(pb + 9);
        if (IN(pb + 10)) { for (int rep_ = 0; rep_ < ((PROBE_DUP_MASK >> 9) & 1) + 1; ++rep_) {
            const PView pv(lds); unsigned char* ws = pv.ws; const int G = fresh_grid(), blk = fresh_blk();
            pg8::Gemm g{(const pg8::bf16_t*)(ws + WS_ACT), (const pg8::bf16_t*)(ws + WS_WDN) + (size_t)l * 32 * 1024 * 1024, NSLOT, 32 * 1024, 1024};
            pg8::MoeOrder<4> S{G, blk, (const int*)(ws + WS_TILEE)};
            pg8::EpiDown E{(pg8::bf16_t*)(ws + WS_Y2), pv.in(I_BDN) + (size_t)l * 32 * 1024};
            pg8::gemm_phase<pg8::EpiDown, pg8::MoeOrder<4>, true, true>(lds, g, S, E);
            convert_fill(lds, l * CONV_PER_L, conv_done_ptr(lds, l, 4), G);
        } } SEAM(pb + 10);
        if (IN(pb + 11)) {
#if PROBE_DUP_MASK & (1 << 19)
            phase_ln2(lds, l, true, Ml);
#endif
            phase_ln2(lds, l, false, Ml); if (l + 1 < DEPTH) convert_drain(lds, l * CONV_PER_L, l * CONV_PER_L + CONV_IN_END); } SEAM(pb + 11);
    }
#undef IN
#undef SEAM
}

extern "C" void kernel_launch(void* const* d_in, const int* in_sizes, int n_in, void* d_out, int out_size, void* d_ws, size_t ws_size, hipStream_t stream) {
    static int grid = 0;
    if (grid == 0) {
        if (n_in != 25 || in_sizes[0] != ML * D || out_size != ML * D || ws_size < WS_END) { fprintf(stderr, "kernel_launch: unexpected problem (n_in %d, in0 %d, out %d, ws %zu < %zu)\n", n_in, n_in > 0 ? in_sizes[0] : -1, out_size, ws_size, (size_t)WS_END); grid = -1; return; }
        int dev = 0, cus = 0, per_cu = 0;
        if (hipGetDevice(&dev) != hipSuccess || hipDeviceGetAttribute(&cus, hipDeviceAttributeMultiprocessorCount, dev) != hipSuccess) { grid = -1; return; }
        if (hipFuncSetAttribute((const void*)fwd_kernel, hipFuncAttributeMaxDynamicSharedMemorySize, LDS_BYTES) != hipSuccess) { fprintf(stderr, "kernel_launch: hipFuncSetAttribute failed\n"); grid = -1; return; }
        if (hipOccupancyMaxActiveBlocksPerMultiprocessor(&per_cu, (const void*)fwd_kernel, 512, LDS_BYTES) != hipSuccess || per_cu < 1) fprintf(stderr, "kernel_launch: occupancy query says %d\n", per_cu);
        (void)hipGetLastError();
        grid = cus;
        if (grid != 256) { fprintf(stderr, "kernel_launch: built for 256 CUs, device has %d\n", cus); grid = (cus >= 256) ? 256 : -1; }
    }
    if (grid < 0) return;
    if (hipMemsetAsync((char*)d_ws + WS_CTL, 0, CTL_ZERO_BYTES, stream) != hipSuccess) return;
    Params a{};
    for (int i = 0; i < 25; ++i) a.in[i] = (const float*)d_in[i];
    a.out = (float*)d_out; a.ws = (unsigned char*)d_ws;
#if MK_PER_PHASE
    for (int ph = 0; ph < N_PHASES; ++ph) { a.ph_lo = ph; a.ph_hi = ph + 1; hipLaunchKernelGGL(fwd_kernel, dim3(grid), dim3(512), LDS_BYTES, stream, a); }
#else
    a.ph_lo = 0; a.ph_hi = N_PHASES;
    hipLaunchKernelGGL(fwd_kernel, dim3(grid), dim3(512), LDS_BYTES, stream, a);
#endif
    const hipError_t le = hipPeekAtLastError();
    if (le != hipSuccess) fprintf(stderr, "kernel_launch: launch failed: %s\n", hipGetErrorName(le));
}
```
